# Optimizing an MI355X kernel written in HIP

```python
import jax, jax.numpy as jnp
from jax import lax
import numpy as np

D_MODEL = 1024
BATCH = 8
SEQ = 2048
DEPTH = 2

GRID_W = 64
CTX_LEN = 256
N_MIXERS = 2
EPS = 1e-6
SSM_EXPAND = 2
D_INNER = SSM_EXPAND * D_MODEL
SSM_HEAD_DIM = 64
SSM_HEADS = D_INNER // SSM_HEAD_DIM
SSM_GROUPS = 8
HEADS_PER_GROUP = SSM_HEADS // SSM_GROUPS
SSM_STATE = 128
SSM_CONV = 3
SSM_CHUNK = 128
XBC_DIM = D_INNER + 2 * SSM_GROUPS * SSM_STATE
SSM_IN_DIM = D_INNER + XBC_DIM + 2 * SSM_HEADS
SC_WIDTH = D_MODEL
SC_CONV = 3
D_FF = 4 * D_MODEL
N_SSD_LAYERS = (DEPTH + 1) // 2
N_SC_LAYERS = DEPTH // 2

kernel_name = "hybrid_ssd_shortconv_prefix_dit"

F32 = jnp.float32


def rms_norm(x, g):
    x32 = x.astype(F32)
    y = x32 * lax.rsqrt(jnp.mean(x32 * x32, axis=-1, keepdims=True) + EPS)
    return y.astype(x.dtype) * g


def modulate(h, shift, scale):
    return h * (1 + scale) + shift


def centred_dwconv(u, w):
    K = w.shape[0]
    p = K // 2
    L = u.shape[1]
    up = jnp.pad(u, ((0, 0), (p, p), (0, 0)))
    return sum(up[:, k:k + L] * w[k] for k in range(K))


def latent_rowconv(u, w):
    b, L, ch = u.shape
    rows = L // GRID_W
    y = centred_dwconv(u.reshape(b * rows, GRID_W, ch), w)
    return y.reshape(b, L, ch)


def ssd_chunked(xh, dt, la, Bm, Cm, h0, want_y):
    b, L = xh.shape[:2]
    Q = SSM_CHUNK
    nc = L // Q
    chunk = lambda t: t.reshape((b, nc, Q) + t.shape[2:])
    xc, dtc, lac, Bc, Cc = chunk(xh), chunk(dt), chunk(la), chunk(Bm), chunk(Cm)
    cs = jnp.cumsum(lac, axis=2)
    total = cs[:, :, -1]
    w_end = jnp.exp(total[:, :, None] - cs) * dtc
    states = jnp.einsum('bckgn,bckgr,bckgrp->bcgrpn', Bc, w_end, xc)

    def step(h, inp):
        dec, s = inp
        return jnp.exp(dec)[..., None, None] * h + s, h

    h_last, h_in = lax.scan(step, h0, (jnp.moveaxis(total, 1, 0), jnp.moveaxis(states, 1, 0)))
    if not want_y:
        return None, h_last
    h_in = jnp.moveaxis(h_in, 0, 1)
    mask = jnp.tril(jnp.ones((Q, Q), dtype=bool))[:, :, None, None]
    seg = cs[:, :, :, None] - cs[:, :, None, :]
    decay = jnp.where(mask, jnp.exp(jnp.where(mask, seg, 0.0)), 0.0)
    cb = jnp.einsum('bcqgn,bckgn->bcqkg', Cc, Bc)
    y_diag = jnp.einsum('bcqkg,bcqkgr,bckgr,bckgrp->bcqgrp', cb, decay, dtc, xc)
    y_off = jnp.einsum('bcqgn,bcqgr,bcgrpn->bcqgrp', Cc, jnp.exp(cs), h_in)
    return (y_diag + y_off).reshape(xh.shape), h_last


def ssd_inputs(h, w_in, conv_w, conv_b, conv_fn):
    b, L, _ = h.shape
    proj = h @ w_in
    z, xbc, dt_raw = jnp.split(proj, [D_INNER, D_INNER + XBC_DIM], axis=-1)
    xbc = jax.nn.silu(conv_fn(xbc, conv_w) + conv_b)
    xs, Bm, Cm = jnp.split(xbc, [D_INNER, D_INNER + SSM_GROUPS * SSM_STATE], axis=-1)
    xh = xs.reshape(b, L, SSM_GROUPS, HEADS_PER_GROUP, SSM_HEAD_DIM)
    Bm = Bm.reshape(b, L, SSM_GROUPS, SSM_STATE)
    Cm = Cm.reshape(b, L, SSM_GROUPS, SSM_STATE)
    dt_raw = dt_raw.reshape(b, L, 2, SSM_GROUPS, HEADS_PER_GROUP)
    return z, xh, Bm, Cm, dt_raw


def ssd_direction(inputs, d, dt_bias, A, h0, want_y):
    _, xh, Bm, Cm, dt_raw = inputs
    dt = jax.nn.softplus(dt_raw[:, :, d].astype(F32) +
                         dt_bias[d].astype(F32).reshape(SSM_GROUPS, HEADS_PER_GROUP))
    la = dt * A[d].reshape(SSM_GROUPS, HEADS_PER_GROUP)
    f = (lambda t: jnp.flip(t, axis=1)) if d == 1 else (lambda t: t)
    y, h_last = ssd_chunked(f(xh.astype(F32)), f(dt), f(la), f(Bm.astype(F32)),
                            f(Cm.astype(F32)), h0, want_y)
    return (f(y) if want_y else None), h_last


def ssd_finish(inputs, y, d_skip, norm_g, w_out):
    z, xh = inputs[0], inputs[1]
    y = y + d_skip.astype(F32).reshape(SSM_GROUPS, HEADS_PER_GROUP, 1) * xh.astype(F32)
    y = y.reshape(z.shape) * jax.nn.silu(z.astype(F32))
    yg = y.reshape(z.shape[:-1] + (SSM_GROUPS, D_INNER // SSM_GROUPS))
    yg = yg * lax.rsqrt(jnp.mean(yg * yg, axis=-1, keepdims=True) + EPS)
    y = yg.reshape(z.shape).astype(z.dtype) * norm_g
    return y @ w_out


def ssd_mixer(h, hc, w_in, conv_w, conv_b, dt_bias, a_log, d_skip, norm_g, w_out, want_ctx_y):
    lat = ssd_inputs(h, w_in, conv_w, conv_b, latent_rowconv)
    con = ssd_inputs(hc, w_in, conv_w, conv_b, centred_dwconv)
    A = -jnp.exp(a_log.astype(F32))
    h0 = jnp.zeros((h.shape[0], SSM_GROUPS, HEADS_PER_GROUP, SSM_HEAD_DIM, SSM_STATE), F32)
    y_lat = 0.0
    y_ctx = 0.0
    for d in range(2):
        yc_d, hc_d = ssd_direction(con, d, dt_bias, A, h0, want_ctx_y)
        yl_d, _ = ssd_direction(lat, d, dt_bias, A, hc_d, True)
        y_lat = y_lat + yl_d
        if want_ctx_y:
            y_ctx = y_ctx + yc_d
    out_lat = ssd_finish(lat, y_lat, d_skip, norm_g, w_out)
    out_ctx = ssd_finish(con, y_ctx, d_skip, norm_g, w_out) if want_ctx_y else None
    return out_lat, out_ctx


def shortconv_mixer(h, w_in, conv_w, w_out, conv_fn):
    Bg, Cg, xv = jnp.split(h @ w_in, 3, axis=-1)
    return (Bg * conv_fn(Cg * xv, conv_w)) @ w_out


def sqrelu_mlp(h, w1, w2):
    return jnp.square(jax.nn.relu(h @ w1)) @ w2


def setup_inputs(seed: int = 0) -> dict:
    key = jax.random.key(seed)
    ks = jax.random.split(key, 24)
    nrm = lambda k, shape, s: jax.random.normal(k, shape, F32) * s
    H = SSM_HEADS
    dt0 = jnp.exp(jax.random.uniform(ks[10], (N_SSD_LAYERS, 2, H), F32,
                                     float(np.log(1e-3)), float(np.log(1e-1))))
    return {
        "x": nrm(ks[0], (BATCH, SEQ, D_MODEL), 1.0),
        "c": nrm(ks[1], (BATCH, D_MODEL), 1.0),
        "ctx": nrm(ks[2], (BATCH, CTX_LEN, D_MODEL), 1.0),
        "c_ctx": nrm(ks[3], (D_MODEL,), 1.0),
        "ada_w": nrm(ks[4], (DEPTH, D_MODEL, 6 * D_MODEL), 0.3 * D_MODEL ** -0.5),
        "ada_b": nrm(ks[5], (DEPTH, 6 * D_MODEL), 0.02),
        "norm_mix_g": 1.0 + nrm(ks[6], (DEPTH, D_MODEL), 0.02),
        "norm_mlp_g": 1.0 + nrm(ks[7], (DEPTH, D_MODEL), 0.02),
        "ssd_w_in": nrm(ks[8], (N_SSD_LAYERS, D_MODEL, SSM_IN_DIM), D_MODEL ** -0.5),
        "ssd_conv_w": nrm(ks[9], (N_SSD_LAYERS, SSM_CONV, XBC_DIM), SSM_CONV ** -0.5),
        "ssd_conv_b": nrm(ks[11], (N_SSD_LAYERS, XBC_DIM), 0.02),
        "ssd_dt_bias": dt0 + jnp.log(-jnp.expm1(-dt0)),
        "ssd_a_log": jnp.log(jax.random.uniform(ks[12], (N_SSD_LAYERS, 2, H), F32, 1.0, 16.0)),
        "ssd_d": 1.0 + nrm(ks[13], (N_SSD_LAYERS, H), 0.02),
        "ssd_norm_g": 1.0 + nrm(ks[14], (N_SSD_LAYERS, D_INNER), 0.02),
        "ssd_w_out": nrm(ks[15], (N_SSD_LAYERS, D_INNER, D_MODEL), D_INNER ** -0.5),
        "sc_w_in": nrm(ks[16], (N_SC_LAYERS, D_MODEL, 3 * SC_WIDTH), D_MODEL ** -0.5),
        "sc_conv_w": nrm(ks[17], (N_SC_LAYERS, SC_CONV, SC_WIDTH), SC_CONV ** -0.5),
        "sc_w_out": nrm(ks[18], (N_SC_LAYERS, SC_WIDTH, D_MODEL), SC_WIDTH ** -0.5),
        "mlp_w1": nrm(ks[19], (DEPTH, D_MODEL, D_FF), D_MODEL ** -0.5),
        "mlp_w2": nrm(ks[20], (DEPTH, D_FF, D_MODEL), D_FF ** -0.5),
        "final_norm_g": 1.0 + nrm(ks[21], (D_MODEL,), 0.02),
    }


def reference(x, c, ctx, c_ctx, ada_w, ada_b, norm_mix_g, norm_mlp_g, ssd_w_in, ssd_conv_w,
              ssd_conv_b, ssd_dt_bias, ssd_a_log, ssd_d, ssd_norm_g, ssd_w_out, sc_w_in,
              sc_conv_w, sc_w_out, mlp_w1, mlp_w2, final_norm_g):
    for i in range(DEPTH):
        kind = i % N_MIXERS
        k = i // N_MIXERS
        ctx_after = any(j % N_MIXERS == 0 for j in range(i + 1, DEPTH))
        need_ctx_here = (kind == 0) or ctx_after

        mod = (jax.nn.silu(c) @ ada_w[i] + ada_b[i])[:, None, :]
        sh_m, sc_m, g_m, sh_f, sc_f, g_f = jnp.split(mod, 6, axis=-1)
        h = modulate(rms_norm(x, norm_mix_g[i]), sh_m, sc_m)
        if need_ctx_here:
            mod_c = jax.nn.silu(c_ctx) @ ada_w[i] + ada_b[i]
            csh_m, csc_m, cg_m, csh_f, csc_f, cg_f = jnp.split(mod_c, 6)
            hc = modulate(rms_norm(ctx, norm_mix_g[i]), csh_m, csc_m)

        if kind == 0:
            y, yc = ssd_mixer(h, hc, ssd_w_in[k], ssd_conv_w[k], ssd_conv_b[k], ssd_dt_bias[k],
                              ssd_a_log[k], ssd_d[k], ssd_norm_g[k], ssd_w_out[k], ctx_after)
        else:
            y = shortconv_mixer(h, sc_w_in[k], sc_conv_w[k], sc_w_out[k], latent_rowconv)
            yc = (shortconv_mixer(hc, sc_w_in[k], sc_conv_w[k], sc_w_out[k], centred_dwconv)
                  if ctx_after else None)

        x = x + g_m * y
        x = x + g_f * sqrelu_mlp(modulate(rms_norm(x, norm_mlp_g[i]), sh_f, sc_f),
                                 mlp_w1[i], mlp_w2[i])
        if ctx_after:
            ctx = ctx + cg_m * yc
            ctx = ctx + cg_f * sqrelu_mlp(modulate(rms_norm(ctx, norm_mlp_g[i]), csh_f, csc_f),
                                          mlp_w1[i], mlp_w2[i])
    return rms_norm(x, final_norm_g)
```

```cpp
#include <hip/hip_runtime.h>
#include <hip/hip_cooperative_groups.h>
#include <cstdio>
namespace cg = cooperative_groups;
__device__ __forceinline__ int pg8_tid_fresh() { int t = threadIdx.x; asm volatile("" : "+v"(t)); return t; }
namespace pg8 {
#define PG8_LAS __attribute__((address_space(3)))
typedef unsigned short bf16_t;
typedef short bf16x8 __attribute__((ext_vector_type(8)));
typedef float f32x4 __attribute__((ext_vector_type(4)));
typedef unsigned u32x4 __attribute__((ext_vector_type(4)));
constexpr int BM = 256, BK = 64, HALF = 128, HTB = HALF * BK * 2  , STAGE_BYTES = 8 * HTB, NXCD = 8, WGM = 8;

__host__ __device__ __forceinline__ int lds_byte(int r, int c) { const int st = (r >> 4) * 2 + (c >> 5), rr = r & 15, cc = c & 31, ob = rr * 64 + cc * 2; return st * 1024 + (ob ^ (((ob >> 9) & 1) << 5)); }
__host__ __device__ __forceinline__ void stage_rc(int b, int& R, int& C) { const int st = b / 1024, sb = b % 1024, swz = sb ^ (((sb >> 9) & 1) << 5); R = (st >> 1) * 16 + swz / 64; C = (st & 1) * 32 + (swz % 64) / 2; }
__host__ __device__ __forceinline__ int perm32(int rho) { const int n = rho >> 4, i = rho & 15; return 8 * (i >> 2) + 4 * n + (i & 3); }

struct Unit { int pm, pn; };
struct Gemm { const bf16_t* A; const bf16_t* Bt; int M, N, K; };

struct StaticOrder {
    int nM, nN, nwg, G, c;
    __host__ __device__ void init(int M, int N, int G_, int c_) { nM = M / BM; nN = N / BM; nwg = nM * nN; G = G_; c = c_; }
    __host__ __device__ bool next(int i, Unit& u) const {
        const long L = (long)i * G + c; if (L >= nwg) return false;
        int wgid = (int)L; { const int q = nwg / NXCD, r = nwg % NXCD, xcd = wgid % NXCD, off = wgid / NXCD; wgid = (xcd < r ? xcd * (q + 1) : r * (q + 1) + (xcd - r) * q) + off; }
        const int nig = WGM * nN, gid = wgid / nig, fm = gid * WGM, gsz = (nM - fm) < WGM ? (nM - fm) : WGM;
        u.pm = fm + ((wgid % nig) % gsz); u.pn = (wgid % nig) / gsz; return true;
    }
    __device__ __forceinline__ void a_ready(const Unit&) const {}
    __device__ __forceinline__ void done(const Unit&) const {}
};
__device__ __forceinline__ unsigned cvt_pk_bf16(float lo, float hi) { unsigned r; asm volatile("v_cvt_pk_bf16_f32 %0, %1, %2" : "=v"(r) : "v"(lo), "v"(hi)); return r; }
template <class Epi, class Sched, bool STAMP = false>
__device__ __forceinline__ void gemm_phase(PG8_LAS unsigned char* lds, const Gemm g, const Sched& S, const Epi& E, unsigned long long* stamps) {
    const int tid = pg8_tid_fresh(), wid = __builtin_amdgcn_readfirstlane(tid >> 6), lane = tid & 63, wr = wid >> 2, wc = wid & 3, fr = lane & 15, fq = lane >> 4;
    const int K = g.K, nt = K / BK;
    int ts_lo = 0, ts_hi = 0, nts = 0; const unsigned long long rt_entry = STAMP ? (unsigned long long)wall_clock64() : 0ull;
#define PG8_STAMP() do { if (STAMP && wid == 0 && nts < 64) { const unsigned long long _c = (unsigned long long)clock64(); \
        ts_lo = (lane == nts) ? (int)(unsigned)_c : ts_lo; ts_hi = (lane == nts) ? (int)(unsigned)(_c >> 32) : ts_hi; ++nts; } } while (0)
    PG8_STAMP();
    unsigned voffA[2], voffB[2];
#pragma unroll
    for (int i = 0; i < 2; ++i) { int R, C; stage_rc(tid * 16 + i * 8192, R, C); const int Rb = Epi::PERM ? ((R & ~31) + perm32(R & 31)) : R;
        voffA[i] = (unsigned)(R * K + C) * 2u; voffB[i] = (unsigned)(Rb * K + C) * 2u; }
    const size_t kstep = (size_t)(BK * 2);
    const size_t hstep = (size_t)HALF * K * 2;
    const size_t tstep = 2 * hstep;
    const unsigned ldsw = (unsigned)wid * 1024u;
    const int aoff = lds_byte(wr * 64 + fr, fq * 8), boff = lds_byte(wc * 32 + fr, fq * 8);
#define PG8_SA(b, h) (((b) * 2 + (h)) * HTB)
#define PG8_SB(b, h) ((4 + (b) * 2 + (h)) * HTB)
#define PG8_STAGE(bufoff, gbase, voff) do { _Pragma("unroll") for (int _i = 0; _i < 2; ++_i) \
        __builtin_amdgcn_global_load_lds((const unsigned*)((const char*)(gbase) + (voff)[_i]), (PG8_LAS unsigned*)(lds + (bufoff) + ldsw + _i * 8192), 16, 0, 0); } while (0)
#define PG8_LDA(dst, b, h) do { _Pragma("unroll") for (int m = 0; m < 4; ++m) _Pragma("unroll") for (int k = 0; k < 2; ++k) dst[m][k] = *(const PG8_LAS bf16x8*)(lds + PG8_SA(b, h) + aoff + m * 2048 + k * 1024); } while (0)
#define PG8_LDB(dst, b, h) do { _Pragma("unroll") for (int n = 0; n < 2; ++n) _Pragma("unroll") for (int k = 0; k < 2; ++k) dst[n][k] = *(const PG8_LAS bf16x8*)(lds + PG8_SB(b, h) + boff + n * 2048 + k * 1024); } while (0)
#define PG8_MMA(ai, bj, At, Bt) do { __builtin_amdgcn_s_setprio(1); _Pragma("unroll") for (int m = 0; m < 4; ++m) _Pragma("unroll") for (int n = 0; n < 2; ++n) _Pragma("unroll") for (int k = 0; k < 2; ++k) \
        acc[ai][bj][m][n] = __builtin_amdgcn_mfma_f32_16x16x32_bf16(Bt[n][k], At[m][k], acc[ai][bj][m][n], 0, 0, 0); __builtin_amdgcn_s_setprio(0); } while (0)
#define PG8_WAIT_V(n) asm volatile("s_waitcnt vmcnt(" #n ")" ::: "memory")
#define PG8_WAIT_L(n) asm volatile("s_waitcnt lgkmcnt(" #n ")" ::: "memory")
#define PG8_BAR __builtin_amdgcn_s_barrier()
#define PG8_SCHED __builtin_amdgcn_sched_barrier(0)
    Unit cur, nxt; int ui = 0;
    if (!S.next(0, cur)) return;
    f32x4 acc[2][2][4][2];
#pragma unroll
    for (int a = 0; a < 2; ++a)
#pragma unroll
        for (int b = 0; b < 2; ++b)
#pragma unroll
            for (int m = 0; m < 4; ++m)
#pragma unroll
                for (int n = 0; n < 2; ++n) acc[a][b][m][n] = (f32x4){0.f, 0.f, 0.f, 0.f};
    bf16x8 At[4][2], B0[2][2], B1[2][2];
    const char* cA = (const char*)g.A + (size_t)cur.pm * tstep; const char* cB = (const char*)g.Bt + (size_t)cur.pn * tstep;
    S.a_ready(cur);
    PG8_STAGE(PG8_SB(0, 0), cB, voffB); PG8_STAGE(PG8_SA(0, 0), cA, voffA); PG8_STAGE(PG8_SB(0, 1), cB + hstep, voffB); PG8_STAGE(PG8_SA(0, 1), cA + hstep, voffA);
    if (wr == 1) PG8_BAR;
    PG8_WAIT_V(4); PG8_BAR;
    PG8_STAGE(PG8_SB(1, 0), cB + kstep, voffB); PG8_STAGE(PG8_SA(1, 0), cA + kstep, voffA); PG8_STAGE(PG8_SB(1, 1), cB + hstep + kstep, voffB);
    PG8_WAIT_V(6); PG8_BAR;
    PG8_STAMP();
    for (;;) {
        const bool has_next = S.next(ui + 1, nxt);
        const char* nA = has_next ? (const char*)g.A + (size_t)nxt.pm * tstep : cA; const char* nB = has_next ? (const char*)g.Bt + (size_t)nxt.pn * tstep : cB;
        for (int t = 0; t < nt; t += 2) {
            const bool last = (t == nt - 2);
            const char* a1 = cA + (size_t)(t + 1) * kstep;
            const char* a2 = last ? nA : cA + (size_t)(t + 2) * kstep; const char* b2 = last ? nB : cB + (size_t)(t + 2) * kstep;
            const char* a3 = a2 + kstep; const char* b3 = b2 + kstep;
            if (last && has_next) S.a_ready(nxt);
            PG8_LDB(B0, 0, 0); PG8_SCHED; PG8_LDA(At, 0, 0); PG8_STAGE(PG8_SA(1, 1), a1 + hstep, voffA);
            PG8_WAIT_L(8); PG8_BAR; PG8_WAIT_L(0); PG8_MMA(0, 0, At, B0); PG8_BAR; PG8_SCHED;
            PG8_LDB(B1, 0, 1); PG8_STAGE(PG8_SB(0, 0), b2, voffB);
            PG8_BAR; PG8_WAIT_L(0); PG8_MMA(0, 1, At, B1); PG8_BAR;
            PG8_LDA(At, 0, 1); PG8_STAGE(PG8_SA(0, 0), a2, voffA);
            PG8_BAR; PG8_WAIT_L(0); PG8_MMA(1, 0, At, B0); PG8_BAR; PG8_SCHED;
            PG8_STAGE(PG8_SB(0, 1), b2 + hstep, voffB);
            PG8_WAIT_V(6); PG8_BAR; PG8_MMA(1, 1, At, B1); PG8_BAR;
            PG8_LDB(B0, 1, 0); PG8_SCHED; PG8_LDA(At, 1, 0); PG8_STAGE(PG8_SA(0, 1), a2 + hstep, voffA);
            PG8_WAIT_L(8); PG8_BAR; PG8_WAIT_L(0); PG8_MMA(0, 0, At, B0); PG8_BAR; PG8_SCHED;
            PG8_LDB(B1, 1, 1); PG8_STAGE(PG8_SB(1, 0), b3, voffB);
            PG8_BAR; PG8_WAIT_L(0); PG8_MMA(0, 1, At, B1); PG8_BAR;
            PG8_LDA(At, 1, 1); PG8_STAGE(PG8_SA(1, 0), a3, voffA);
            PG8_BAR; PG8_WAIT_L(0); PG8_MMA(1, 0, At, B0); PG8_BAR; PG8_SCHED;
            PG8_STAGE(PG8_SB(1, 1), b3 + hstep, voffB);
            PG8_WAIT_V(6); PG8_BAR; PG8_MMA(1, 1, At, B1); PG8_BAR;
        }
        PG8_STAMP();
        if constexpr (!Epi::AFTER_DRAIN) { E(acc, cur, wr, wc, fr, fq); S.done(cur); }
        PG8_STAMP();
        if (!has_next) break;
#pragma unroll
        for (int a = 0; a < 2; ++a)
#pragma unroll
            for (int b = 0; b < 2; ++b)
#pragma unroll
                for (int m = 0; m < 4; ++m)
#pragma unroll
                    for (int n = 0; n < 2; ++n) acc[a][b][m][n] = (f32x4){0.f, 0.f, 0.f, 0.f};
        cur = nxt; cA = nA; cB = nB; ++ui;
    }
    PG8_WAIT_V(0);
    if (wr == 0) PG8_BAR;
    PG8_BAR;
    if constexpr (Epi::AFTER_DRAIN) { E.fused(acc, cur, wr, wc, fr, fq, lds, wid, lane); S.done(cur); }
    PG8_STAMP();
    if (STAMP && wid == 0) { stamps[lane] = lane < nts ? (((unsigned long long)(unsigned)ts_hi << 32) | (unsigned)ts_lo) : 0ull;
        if (lane == 62) stamps[62] = rt_entry; if (lane == 63) stamps[63] = (unsigned long long)wall_clock64(); }
#undef PG8_STAMP
#undef PG8_SA
#undef PG8_SB
#undef PG8_STAGE
#undef PG8_LDA
#undef PG8_LDB
#undef PG8_MMA
#undef PG8_WAIT_V
#undef PG8_WAIT_L
#undef PG8_BAR
#undef PG8_SCHED
}
}
using pg8::bf16_t; using pg8::bf16x8; using pg8::f32x4; using pg8::u32x4; using pg8::Unit; using pg8::cvt_pk_bf16;
typedef __attribute__((address_space(3))) unsigned char* ldsp;
typedef unsigned u32x2 __attribute__((ext_vector_type(2)));
typedef short s16x4 __attribute__((ext_vector_type(4)));
typedef short v4i16_t __attribute__((ext_vector_type(4)));
#define LASQ __attribute__((address_space(3)))

constexpr int NT = 512, LDS_BYTES = 131072;
constexpr size_t WS_MOD = 0, WS_SSQ = 524288, WS_WIN = 1048576, WS_WOUT = WS_WIN + 13107200, WS_XBC = WS_WOUT + 4194304, WS_DT = WS_XBC + 150994944,
                 WS_R = WS_DT + 4718592, WS_XBCC = WS_R + 67108864, WS_END_A = WS_XBCC + 16777216;
constexpr size_t WS_U = WS_XBC, WS_SCP = WS_XBC, WS_SCV = WS_XBC + 100663296, WS_W1T = WS_R + 33554432, WS_W2T = WS_W1T + 16777216,
                 WS_SCIN = WS_W2T + 16777216, WS_SCOUT = WS_SCIN + 6291456, WS_END_B = WS_SCOUT + 2097152;
static_assert(WS_END_A <= 268435456 && WS_END_B <= 268435456 && WS_SCV + 33554432 <= WS_DT, "workspace map");

struct Params { const float* in[22]; float* out; unsigned char* ws; };

__device__ __forceinline__ float wave_sum(float v) {
#pragma unroll
    for (int o = 32; o >= 1; o >>= 1) v += __shfl_xor(v, o);
    return v; }
__device__ __forceinline__ float silu_f(float v) { return v * __builtin_amdgcn_rcpf(1.0f + __expf(-v)); }
__device__ __forceinline__ float softplus_f(float x) { return x > 20.f ? x : log1pf(__expf(x)); }
__device__ __forceinline__ float bf_lo(unsigned u) { return __uint_as_float(u << 16); }
__device__ __forceinline__ float bf_hi(unsigned u) { return __uint_as_float(u & 0xffff0000u); }

__device__ __forceinline__ void phase_ada(const Params& p, unsigned char* lds) {
    const int tidx = pg8_tid_fresh();
    float* s_c = (float*)lds;
    float* part = (float*)(lds + 36864);
    float* mod = (float*)(p.ws + WS_MOD);
    const int tid = tidx;
    for (int i = tid; i < 9 * 1024; i += NT) { const int b = i >> 10, k = i & 1023; const float v = b < 8 ? p.in[1][b * 1024 + k] : p.in[3][k]; s_c[i] = silu_f(v); }
    __syncthreads();
    for (int item = blockIdx.x; item < 256; item += gridDim.x) {
        const int l = item >> 7, col0 = (item & 127) * 48;
        const float* W = p.in[4] + (size_t)l * 1024 * 6144;
        if (tid < 384) {
            const int c4 = tid % 12, ks = tid / 12;
            float acc[9][4];
#pragma unroll
            for (int b = 0; b < 9; ++b)
#pragma unroll
                for (int j = 0; j < 4; ++j) acc[b][j] = 0.f;
            for (int kk = 0; kk < 32; ++kk) {
                const int k = ks + 32 * kk; const f32x4 w = *(const f32x4*)(W + (size_t)k * 6144 + col0 + c4 * 4);
#pragma unroll
                for (int b = 0; b < 9; ++b) { const float s = s_c[b * 1024 + k];
#pragma unroll
                    for (int j = 0; j < 4; ++j) acc[b][j] += s * w[j]; }
            }
#pragma unroll
            for (int b = 0; b < 9; ++b)
#pragma unroll
                for (int j = 0; j < 4; ++j) part[(ks * 9 + b) * 48 + c4 * 4 + j] = acc[b][j];
        }
        __syncthreads();
        if (tid < 432) { const int b = tid / 48, j = tid % 48; float s = p.in[5][l * 6144 + col0 + j];
            for (int ks = 0; ks < 32; ++ks) s += part[(ks * 9 + b) * 48 + j];
            mod[(l * 9 + b) * 6144 + col0 + j] = s; }
        __syncthreads();
    }
}
__device__ __forceinline__ void tr_tile(const float* W, int K, int N, bf16_t* Wt, int tk, int tn, float* tl) {
    const int tidx = pg8_tid_fresh();
    const int tid = tidx;
#pragma unroll
    for (int i = 0; i < 2; ++i) { const int idx = tid + 512 * i, r = idx >> 4, c4 = idx & 15;
        const f32x4 v = *(const f32x4*)(W + (size_t)(tk * 64 + r) * N + tn * 64 + c4 * 4); float* d = tl + r * 65 + c4 * 4; d[0] = v[0]; d[1] = v[1]; d[2] = v[2]; d[3] = v[3]; }
    __syncthreads();
    { const int n = tid >> 3, k8 = tid & 7; float f[8];
#pragma unroll
      for (int j = 0; j < 8; ++j) f[j] = tl[(k8 * 8 + j) * 65 + n];
      u32x4 w; w.x = cvt_pk_bf16(f[0], f[1]); w.y = cvt_pk_bf16(f[2], f[3]); w.z = cvt_pk_bf16(f[4], f[5]); w.w = cvt_pk_bf16(f[6], f[7]);
      *(u32x4*)(Wt + (size_t)(tn * 64 + n) * K + tk * 64 + k8 * 8) = w; }
    __syncthreads();
}
struct TrJob { const float* W; bf16_t* Wt; int K, N; };
__device__ __forceinline__ void tr_job(const TrJob& j, int& g, int& base, float* tl) {
    const int ntn = j.N / 64, nt = (j.K / 64) * ntn;
    while (g < base + nt) { const int local = g - base; tr_tile(j.W, j.K, j.N, j.Wt, local / ntn, local % ntn, tl); g += gridDim.x; }
    base += nt;
}

__device__ __forceinline__ void norm_rows(const float* src, int nrows, int bfix, const float* g, const float* modl, int osh, int osc, bf16_t* dst) {
    const int tidx = pg8_tid_fresh();
    const int lane = tidx & 63, wave = tidx >> 6;
    for (int r = blockIdx.x * 8 + wave; r < nrows; r += gridDim.x * 8) {
        const float* xr = src + (size_t)r * 1024; f32x4 v[4]; float ss = 0.f;
#pragma unroll
        for (int i = 0; i < 4; ++i) { v[i] = *(const f32x4*)(xr + i * 256 + lane * 4); ss += v[i][0] * v[i][0] + v[i][1] * v[i][1] + v[i][2] * v[i][2] + v[i][3] * v[i][3]; }
        ss = wave_sum(ss); const float rstd = rsqrtf(ss * (1.0f / 1024.0f) + 1e-6f);
        const int b = bfix >= 0 ? bfix : (r >> 11);
        const float* mb = modl + b * 6144;
#pragma unroll
        for (int i = 0; i < 4; ++i) { const int col = i * 256 + lane * 4; const f32x4 gg = *(const f32x4*)(g + col), sh = *(const f32x4*)(mb + osh + col), sc = *(const f32x4*)(mb + osc + col);
            const f32x4 o = (v[i] * rstd * gg) * (sc + 1.0f) + sh; u32x2 w; w.x = cvt_pk_bf16(o[0], o[1]); w.y = cvt_pk_bf16(o[2], o[3]);
            *(u32x2*)(dst + (size_t)r * 1024 + col) = w; }
    }
}
__device__ __forceinline__ void final_norm(float* x, const float* g) {
    const int tidx = pg8_tid_fresh();
    const int lane = tidx & 63, wave = tidx >> 6;
    for (int r = blockIdx.x * 8 + wave; r < 16384; r += gridDim.x * 8) {
        float* xr = x + (size_t)r * 1024; f32x4 v[4]; float ss = 0.f;
#pragma unroll
        for (int i = 0; i < 4; ++i) { v[i] = *(const f32x4*)(xr + i * 256 + lane * 4); ss += v[i][0] * v[i][0] + v[i][1] * v[i][1] + v[i][2] * v[i][2] + v[i][3] * v[i][3]; }
        ss = wave_sum(ss); const float rstd = rsqrtf(ss * (1.0f / 1024.0f) + 1e-6f);
#pragma unroll
        for (int i = 0; i < 4; ++i) { const int col = i * 256 + lane * 4; const f32x4 gg = *(const f32x4*)(g + col); *(f32x4*)(xr + col) = v[i] * rstd * gg; }
    }
}

struct InProjOrder {
    pg8::StaticOrder so; int G, c;
    __device__ __forceinline__ void init(int G_, int c_) { so.init(16384, 6400, G_, c_); G = G_; c = c_; }
    __device__ __forceinline__ bool next(int i, Unit& u) const {
        int L = i * G + c; if (L < 1600) return so.next(i, u);
        L -= 1600; if (L >= 136) return false;
        u.pm = 64 + (L & 7); u.pn = 8 + (L >> 3); return true; }
    __device__ __forceinline__ void a_ready(const Unit&) const {}
    __device__ __forceinline__ void done(const Unit&) const {}
};
struct EpiInProj {
    static constexpr bool PERM = true, AFTER_DRAIN = false;
    bf16_t* z; bf16_t* xbc; float* dt;
    __device__ __forceinline__ void operator()(const f32x4 (&acc)[2][2][4][2], const Unit& u, int wr, int wc, int fr, int fq) const {
        const int row0 = u.pm * 256 + wr * 64 + fr;
        if (u.pn == 24) {
            if (wc < 2) {
#pragma unroll
                for (int ai = 0; ai < 2; ++ai)
#pragma unroll
                    for (int m = 0; m < 4; ++m) { float* rp = dt + (size_t)(row0 + ai * 128 + m * 16) * 64 + wc * 32 + 8 * fq; *(f32x4*)rp = acc[ai][0][m][0]; *(f32x4*)(rp + 4) = acc[ai][0][m][1]; }
            }
            return;
        }
        bf16_t* base; int ldc, colt;
        if (u.pn < 8) { base = z; ldc = 2048; colt = u.pn * 256; } else { base = xbc; ldc = 4096; colt = (u.pn - 8) * 256; }
        const int col0 = colt + wc * 32 + 8 * fq;
#pragma unroll
        for (int ai = 0; ai < 2; ++ai)
#pragma unroll
            for (int m = 0; m < 4; ++m) { bf16_t* rowp = base + (size_t)(row0 + ai * 128 + m * 16) * ldc + col0;
#pragma unroll
                for (int bj = 0; bj < 2; ++bj) { const f32x4 v0 = acc[ai][bj][m][0], v1 = acc[ai][bj][m][1];
                    u32x4 w; w.x = cvt_pk_bf16(v0[0], v0[1]); w.y = cvt_pk_bf16(v0[2], v0[3]); w.z = cvt_pk_bf16(v1[0], v1[1]); w.w = cvt_pk_bf16(v1[2], v1[3]);
                    *(u32x4*)(rowp + bj * 128) = w; } }
    }
};
struct EpiAct {
    static constexpr bool PERM = true, AFTER_DRAIN = false;
    bf16_t* O; int ldc; int act;
    __device__ __forceinline__ void operator()(const f32x4 (&acc)[2][2][4][2], const Unit& u, int wr, int wc, int fr, int fq) const {
        const int row0 = u.pm * 256 + wr * 64 + fr, col0 = u.pn * 256 + wc * 32 + 8 * fq;
#pragma unroll
        for (int ai = 0; ai < 2; ++ai)
#pragma unroll
            for (int m = 0; m < 4; ++m) { bf16_t* rowp = O + (size_t)(row0 + ai * 128 + m * 16) * ldc + col0;
#pragma unroll
                for (int bj = 0; bj < 2; ++bj) { f32x4 v0 = acc[ai][bj][m][0], v1 = acc[ai][bj][m][1];
                    if (act) {
#pragma unroll
                        for (int j = 0; j < 4; ++j) { const float a = fmaxf(v0[j], 0.f), b = fmaxf(v1[j], 0.f); v0[j] = a * a; v1[j] = b * b; } }
                    u32x4 w; w.x = cvt_pk_bf16(v0[0], v0[1]); w.y = cvt_pk_bf16(v0[2], v0[3]); w.z = cvt_pk_bf16(v1[0], v1[1]); w.w = cvt_pk_bf16(v1[2], v1[3]);
                    *(u32x4*)(rowp + bj * 128) = w; } }
    }
};
struct EpiRes {
    static constexpr bool PERM = false, AFTER_DRAIN = false;
    const float* xin; float* out; const float* gate;
    __device__ __forceinline__ void operator()(const f32x4 (&acc)[2][2][4][2], const Unit& u, int wr, int wc, int fr, int fq) const {
        const int row0 = u.pm * 256 + wr * 64 + fr, col0 = u.pn * 256 + wc * 32 + 4 * fq, b = u.pm >> 3;
        f32x4 gv[2][2];
#pragma unroll
        for (int bj = 0; bj < 2; ++bj)
#pragma unroll
            for (int n = 0; n < 2; ++n) gv[bj][n] = *(const f32x4*)(gate + b * 6144 + col0 + bj * 128 + n * 16);
#pragma unroll
        for (int ai = 0; ai < 2; ++ai)
#pragma unroll
            for (int m = 0; m < 4; ++m) { const size_t off = (size_t)(row0 + ai * 128 + m * 16) * 1024 + col0;
#pragma unroll
                for (int bj = 0; bj < 2; ++bj)
#pragma unroll
                    for (int n = 0; n < 2; ++n) { const f32x4 xv = *(const f32x4*)(xin + off + bj * 128 + n * 16); *(f32x4*)(out + off + bj * 128 + n * 16) = xv + gv[bj][n] * acc[ai][bj][m][n]; }
                asm volatile("" ::: "memory"); }
    }
};

__device__ __forceinline__ void unpack8(const u32x4 v, float (&f)[8]) { f[0] = bf_lo(v.x); f[1] = bf_hi(v.x); f[2] = bf_lo(v.y); f[3] = bf_hi(v.y); f[4] = bf_lo(v.z); f[5] = bf_hi(v.z); f[6] = bf_lo(v.w); f[7] = bf_hi(v.w); }
__device__ __forceinline__ void phase_conv(const Params& p) {
    const int tidx = pg8_tid_fresh();
    const int lane = tidx & 63, wave = tidx >> 6;
    bf16_t* xbc = (bf16_t*)(p.ws + WS_XBC); bf16_t* xbcc = (bf16_t*)(p.ws + WS_XBCC);
    const float* cw = p.in[9]; const float* cb = p.in[10];
    for (int item = wave * gridDim.x + blockIdx.x; item < 2304; item += gridDim.x * 8) {
        const int seg = item >> 3, slab = item & 7, ch = slab * 512 + lane * 8;
        const bf16_t* src; bf16_t* dst; bool has_prev = false, has_next = false;
        if (seg < 256) { src = xbc + (size_t)seg * 64 * 4096 + ch; dst = xbc + (size_t)seg * 64 * 4096 + ch; }
        else { const int cs = seg - 256, q = cs & 3; src = xbc + (size_t)(16384 + cs * 64) * 4096 + ch; dst = xbcc + (size_t)cs * 64 * 4096 + ch; has_prev = q > 0; has_next = q < 3; }
        float w0[8], w1[8], w2[8], bb[8];
#pragma unroll
        for (int h = 0; h < 2; ++h) { const f32x4 a = *(const f32x4*)(cw + ch + 4 * h), b = *(const f32x4*)(cw + 4096 + ch + 4 * h), c = *(const f32x4*)(cw + 8192 + ch + 4 * h), d = *(const f32x4*)(cb + ch + 4 * h);
#pragma unroll
            for (int j = 0; j < 4; ++j) { w0[4 * h + j] = a[j]; w1[4 * h + j] = b[j]; w2[4 * h + j] = c[j]; bb[4 * h + j] = d[j]; } }
        u32x4 prev = (u32x4){0u, 0u, 0u, 0u};
        if (has_prev) prev = *(const u32x4*)(src - 4096);
        for (int sb = 0; sb < 4; ++sb) {
            u32x4 r[16];
#pragma unroll
            for (int i = 0; i < 16; ++i) r[i] = *(const u32x4*)(src + (size_t)(sb * 16 + i) * 4096);
            u32x4 nxt = (u32x4){0u, 0u, 0u, 0u};
            if (sb < 3 || has_next) nxt = *(const u32x4*)(src + (size_t)(sb * 16 + 16) * 4096);
            float fp[8], fc[8], fn[8];
            unpack8(prev, fp); unpack8(r[0], fc);
#pragma unroll
            for (int i = 0; i < 16; ++i) {
                unpack8(i < 15 ? r[i < 15 ? i + 1 : 15] : nxt, fn);
                float o[8];
#pragma unroll
                for (int j = 0; j < 8; ++j) { o[j] = silu_f(w0[j] * fp[j] + w1[j] * fc[j] + w2[j] * fn[j] + bb[j]); fp[j] = fc[j]; fc[j] = fn[j]; }
                u32x4 w; w.x = cvt_pk_bf16(o[0], o[1]); w.y = cvt_pk_bf16(o[2], o[3]); w.z = cvt_pk_bf16(o[4], o[5]); w.w = cvt_pk_bf16(o[6], o[7]);
                *(u32x4*)(dst + (size_t)(sb * 16 + i) * 4096) = w;
            }
            prev = r[15];
        }
    }
}

__device__ __forceinline__ bf16x8 ld_frag(ldsp L, int off) { return *(const LASQ bf16x8*)(L + off); }
__device__ __forceinline__ s16x4 tr4(ldsp L, int off) { return __builtin_bit_cast(s16x4, __builtin_amdgcn_ds_read_tr16_b64_v4i16((LASQ v4i16_t*)(L + off))); }
__device__ __forceinline__ bf16x8 tr_frag(ldsp L, int off, int stride) { const s16x4 a = tr4(L, off), b = tr4(L, off + 4 * stride); return (bf16x8){a[0], a[1], a[2], a[3], b[0], b[1], b[2], b[3]}; }
__device__ __forceinline__ unsigned scale2(unsigned u, float s0, float s1) { return cvt_pk_bf16(bf_lo(u) * s0, bf_hi(u) * s1); }
#define MFMA16(a, b, c) __builtin_amdgcn_mfma_f32_16x16x32_bf16((a), (b), (c), 0, 0, 0)

__device__ __forceinline__ void phase_ssd(const Params& p, ldsp L) {
    const int tidx = pg8_tid_fresh();
    constexpr int RS = 272, RSX = 144, CN = 0, BN = 34816, XS = 69632, HB = 88064, CSO = 105472, WO = 105984, TOTO = 106496;
    const int tid = tidx, lane = tid & 63, w = __builtin_amdgcn_readfirstlane(tid >> 6), fr = lane & 15, fq = lane >> 4, q4 = fr >> 2, p4 = fr & 3;
    const bf16_t* xbc = (const bf16_t*)(p.ws + WS_XBC); const bf16_t* xbcc = (const bf16_t*)(p.ws + WS_XBCC);
    const float* dtb = (const float*)(p.ws + WS_DT); const bf16_t* zb = (const bf16_t*)p.out; bf16_t* yb = (bf16_t*)(p.ws + WS_R); float* ssq = (float*)(p.ws + WS_SSQ);
    LASQ float* csf = (LASQ float*)(L + CSO); LASQ float* wf = (LASQ float*)(L + WO); LASQ float* totf = (LASQ float*)(L + TOTO);
    const int pw = w & 3, nb0 = (w >> 2) * 4, trow = 16 * w + fr;
    for (int it = blockIdx.x; it < 256; it += gridDim.x) {
        const int xcd = it & 7, slot = it >> 3, pgi = xcd * 8 + (slot >> 2), r = slot & 3, b = pgi >> 3, g = pgi & 7, head = g * 4 + r;
        const float Dh = p.in[13][head];
#pragma unroll 1
        for (int dir = 0; dir < 2; ++dir) {
            const float A = -__expf(p.in[12][dir * 32 + head]); const float dtbias = p.in[11][dir * 32 + head];
            f32x4 hacc[4];
#pragma unroll
            for (int i = 0; i < 4; ++i) hacc[i] = (f32x4){0.f, 0.f, 0.f, 0.f};
#pragma unroll 1
            for (int step = 0; step < 18; ++step) {
                const bool isctx = step < 2;
                const int c = isctx ? (dir ? 1 - step : step) : (dir ? 17 - step : step - 2);
                const bf16_t* src = isctx ? xbcc + (size_t)(b * 256 + c * 128) * 4096 : xbc + (size_t)(b * 2048 + c * 128) * 4096;
                const int grow0 = isctx ? 16384 + b * 256 + c * 128 : b * 2048 + c * 128;
                const float* dtp = dtb + (size_t)grow0 * 64 + dir * 32 + head;
#pragma unroll
                for (int i = 0; i < 2; ++i) { const int id = tid + 512 * i, row = id >> 3, pc = id & 7;
                    const float dtv = softplus_f(dtp[row * 64] + dtbias);
                    u32x4 v = *(const u32x4*)(src + (size_t)row * 4096 + head * 64 + pc * 8);
                    v.x = scale2(v.x, dtv, dtv); v.y = scale2(v.y, dtv, dtv); v.z = scale2(v.z, dtv, dtv); v.w = scale2(v.w, dtv, dtv);
                    *(LASQ u32x4*)(L + XS + row * RSX + pc * 16) = v; }
#pragma unroll
                for (int i = 0; i < 4; ++i) { const int id = tid + 512 * i, row = id >> 4, pc = id & 15;
                    const u32x4 vb = *(const u32x4*)(src + (size_t)row * 4096 + 2048 + g * 128 + pc * 8);
                    const u32x4 vc = *(const u32x4*)(src + (size_t)row * 4096 + 3072 + g * 128 + pc * 8);
                    *(LASQ u32x4*)(L + BN + row * RS + pc * 16) = vb; *(LASQ u32x4*)(L + CN + row * RS + pc * 16) = vc; }
                if (!isctx) {
#pragma unroll
                    for (int i = 0; i < 4; ++i) { u32x2 hw; hw.x = cvt_pk_bf16(hacc[i][0], hacc[i][1]); hw.y = cvt_pk_bf16(hacc[i][2], hacc[i][3]);
                        *(LASQ u32x2*)(L + HB + (16 * pw + fr) * RS + (16 * (nb0 + i) + 4 * fq) * 2) = hw; }
                }
                if (w == 0) {
                    const float a0 = softplus_f(dtp[lane * 64] + dtbias) * A, a1 = softplus_f(dtp[(64 + lane) * 64] + dtbias) * A;
                    float p0 = a0, p1 = a1;
#pragma unroll
                    for (int o = 1; o < 64; o <<= 1) { const float t0 = __shfl_up(p0, o), t1 = __shfl_up(p1, o); if (lane >= o) { p0 += t0; p1 += t1; } }
                    p1 += __shfl(p0, 63);
                    const float total = __shfl(p1, 63);
                    if (dir) { p0 = total - p0 + a0; p1 = total - p1 + a1; }
                    csf[lane] = p0; csf[64 + lane] = p1; wf[lane] = __expf(total - p0); wf[64 + lane] = __expf(total - p1);
                    if (lane == 0) totf[0] = total;
                }
                __syncthreads();
                const float total = totf[0];
                if (!isctx) {
                    const float cst = csf[trow];
                    bf16x8 cf[4];
#pragma unroll
                    for (int ks = 0; ks < 4; ++ks) cf[ks] = ld_frag(L, CN + trow * RS + ks * 64 + fq * 16);
                    f32x4 yacc[4];
#pragma unroll
                    for (int pt = 0; pt < 4; ++pt) { yacc[pt] = (f32x4){0.f, 0.f, 0.f, 0.f};
#pragma unroll
                        for (int ks = 0; ks < 4; ++ks) { const bf16x8 hf = ld_frag(L, HB + (16 * pt + fr) * RS + ks * 64 + fq * 16); yacc[pt] = MFMA16(hf, cf[ks], yacc[pt]); } }
                    const float ect = __expf(cst);
#pragma unroll
                    for (int pt = 0; pt < 4; ++pt) yacc[pt] *= ect;
#pragma unroll
                    for (int st = 0; st < 8; ++st) { f32x4 s = (f32x4){0.f, 0.f, 0.f, 0.f};
#pragma unroll
                        for (int ks = 0; ks < 4; ++ks) { const bf16x8 bfr = ld_frag(L, BN + (16 * st + fr) * RS + ks * 64 + fq * 16); s = MFMA16(bfr, cf[ks], s); }
                        const f32x4 css = *(const LASQ f32x4*)(L + CSO + (16 * st + 4 * fq) * 4);
                        float l[4];
#pragma unroll
                        for (int j = 0; j < 4; ++j) { const int sidx = 16 * st + 4 * fq + j; const bool ok = dir ? (sidx >= trow) : (sidx <= trow);
                            const float e = __expf(fminf(cst - css[j], 0.f)); l[j] = ok ? s[j] * e : 0.f; }
                        u32x2 pk; pk.x = cvt_pk_bf16(l[0], l[1]); pk.y = cvt_pk_bf16(l[2], l[3]);
                        *(LASQ u32x2*)(L + CN + trow * RS + (16 * st + 4 * fq) * 2) = pk; }
                    __builtin_amdgcn_wave_barrier();
#pragma unroll
                    for (int ks = 0; ks < 4; ++ks) { const bf16x8 lf = ld_frag(L, CN + trow * RS + ks * 64 + fq * 16);
#pragma unroll
                        for (int pt = 0; pt < 4; ++pt) { const bf16x8 xf = tr_frag(L, XS + (32 * ks + 8 * fq + q4) * RSX + 32 * pt + 8 * p4, RSX); yacc[pt] = MFMA16(xf, lf, yacc[pt]); } }
                    const size_t grow = (size_t)(grow0 + trow);
                    if (dir == 0) {
#pragma unroll
                        for (int pt = 0; pt < 4; ++pt) { u32x2 o; o.x = cvt_pk_bf16(yacc[pt][0], yacc[pt][1]); o.y = cvt_pk_bf16(yacc[pt][2], yacc[pt][3]);
                            *(u32x2*)(yb + grow * 2048 + head * 64 + 16 * pt + 4 * fq) = o; }
                    } else {
                        float sq = 0.f;
#pragma unroll
                        for (int pt = 0; pt < 4; ++pt) { const int col = head * 64 + 16 * pt + 4 * fq;
                            const u32x2 pv = *(const u32x2*)(yb + grow * 2048 + col), xv = *(const u32x2*)(xbc + grow * 4096 + col), zv = *(const u32x2*)(zb + grow * 2048 + col);
                            const float y0 = (yacc[pt][0] + bf_lo(pv.x) + Dh * bf_lo(xv.x)) * silu_f(bf_lo(zv.x));
                            const float y1 = (yacc[pt][1] + bf_hi(pv.x) + Dh * bf_hi(xv.x)) * silu_f(bf_hi(zv.x));
                            const float y2 = (yacc[pt][2] + bf_lo(pv.y) + Dh * bf_lo(xv.y)) * silu_f(bf_lo(zv.y));
                            const float y3 = (yacc[pt][3] + bf_hi(pv.y) + Dh * bf_hi(xv.y)) * silu_f(bf_hi(zv.y));
                            sq += y0 * y0 + y1 * y1 + y2 * y2 + y3 * y3;
                            u32x2 o; o.x = cvt_pk_bf16(y0, y1); o.y = cvt_pk_bf16(y2, y3);
                            *(u32x2*)(yb + grow * 2048 + col) = o; }
                        sq += __shfl_xor(sq, 16); sq += __shfl_xor(sq, 32);
                        if (fq == 0) atomicAdd(ssq + grow * 8 + g, sq);
                    }
                }
                { const float et = __expf(total);
#pragma unroll
                  for (int i = 0; i < 4; ++i) hacc[i] *= et;
#pragma unroll
                  for (int ks = 0; ks < 4; ++ks) {
                      const bf16x8 xr = tr_frag(L, XS + (32 * ks + 8 * fq + q4) * RSX + 32 * pw + 8 * p4, RSX);
                      const f32x4 wa = *(const LASQ f32x4*)(L + WO + (32 * ks + 8 * fq) * 4), wb = *(const LASQ f32x4*)(L + WO + (32 * ks + 8 * fq + 4) * 4);
                      const u32x4 xu = __builtin_bit_cast(u32x4, xr); u32x4 xs;
                      xs.x = scale2(xu.x, wa[0], wa[1]); xs.y = scale2(xu.y, wa[2], wa[3]); xs.z = scale2(xu.z, wb[0], wb[1]); xs.w = scale2(xu.w, wb[2], wb[3]);
                      const bf16x8 xsf = __builtin_bit_cast(bf16x8, xs);
#pragma unroll
                      for (int i = 0; i < 4; ++i) { const bf16x8 bfr = tr_frag(L, BN + (32 * ks + 8 * fq + q4) * RS + 32 * (nb0 + i) + 8 * p4, RS); hacc[i] = MFMA16(bfr, xsf, hacc[i]); } } }
                __syncthreads();
            }
        }
    }
}

__device__ __forceinline__ void phase_gnorm(const Params& p) {
    const int tidx = pg8_tid_fresh();
    const int lane = tidx & 63, wave = tidx >> 6;
    bf16_t* yb = (bf16_t*)(p.ws + WS_R); const float* ssq = (const float*)(p.ws + WS_SSQ); const float* ng = p.in[14];
    for (int r = blockIdx.x * 8 + wave; r < 16384; r += gridDim.x * 8) {
#pragma unroll
        for (int i = 0; i < 4; ++i) { const int col = i * 512 + lane * 8, grp = col >> 8;
            const float sc = rsqrtf(ssq[(size_t)r * 8 + grp] * (1.0f / 256.0f) + 1e-6f);
            const u32x4 v = *(const u32x4*)(yb + (size_t)r * 2048 + col); const f32x4 g0 = *(const f32x4*)(ng + col), g1 = *(const f32x4*)(ng + col + 4);
            u32x4 o; o.x = cvt_pk_bf16((bf_lo(v.x) * sc) * g0[0], (bf_hi(v.x) * sc) * g0[1]); o.y = cvt_pk_bf16((bf_lo(v.y) * sc) * g0[2], (bf_hi(v.y) * sc) * g0[3]);
            o.z = cvt_pk_bf16((bf_lo(v.z) * sc) * g1[0], (bf_hi(v.z) * sc) * g1[1]); o.w = cvt_pk_bf16((bf_lo(v.w) * sc) * g1[2], (bf_hi(v.w) * sc) * g1[3]);
            *(u32x4*)(yb + (size_t)r * 2048 + col) = o; }
    }
}

__device__ __forceinline__ void phase_scconv(const Params& p) {
    const int tidx = pg8_tid_fresh();
    const int lane = tidx & 63, wave = tidx >> 6;
    const bf16_t* P = (const bf16_t*)(p.ws + WS_SCP); bf16_t* V = (bf16_t*)(p.ws + WS_SCV); const float* cw = p.in[17];
    for (int item = blockIdx.x * 8 + wave; item < 8192; item += gridDim.x * 8) {
        const int rb = item >> 1, half = item & 1, ch = half * 512 + lane * 8, t0 = rb * 4, tin = t0 & 63;
        float w0[8], w1[8], w2[8];
#pragma unroll
        for (int h = 0; h < 2; ++h) { const f32x4 a = *(const f32x4*)(cw + ch + 4 * h), b = *(const f32x4*)(cw + 1024 + ch + 4 * h), c = *(const f32x4*)(cw + 2048 + ch + 4 * h);
#pragma unroll
            for (int j = 0; j < 4; ++j) { w0[4 * h + j] = a[j]; w1[4 * h + j] = b[j]; w2[4 * h + j] = c[j]; } }
        float m[6][8];
#pragma unroll
        for (int i = 0; i < 6; ++i) { const int t = t0 - 1 + i; const bool ok = !((i == 0 && tin == 0) || (i == 5 && tin == 60));
            if (ok) { const u32x4 cg = *(const u32x4*)(P + (size_t)t * 3072 + 1024 + ch), xv = *(const u32x4*)(P + (size_t)t * 3072 + 2048 + ch); float a[8], b[8]; unpack8(cg, a); unpack8(xv, b);
#pragma unroll
                for (int j = 0; j < 8; ++j) m[i][j] = a[j] * b[j]; }
            else {
#pragma unroll
                for (int j = 0; j < 8; ++j) m[i][j] = 0.f; } }
#pragma unroll
        for (int i = 0; i < 4; ++i) { const u32x4 bg = *(const u32x4*)(P + (size_t)(t0 + i) * 3072 + ch); float bgf[8], o[8]; unpack8(bg, bgf);
#pragma unroll
            for (int j = 0; j < 8; ++j) o[j] = bgf[j] * (w0[j] * m[i][j] + w1[j] * m[i + 1][j] + w2[j] * m[i + 2][j]);
            u32x4 w; w.x = cvt_pk_bf16(o[0], o[1]); w.y = cvt_pk_bf16(o[2], o[3]); w.z = cvt_pk_bf16(o[4], o[5]); w.w = cvt_pk_bf16(o[6], o[7]);
            *(u32x4*)(V + (size_t)(t0 + i) * 1024 + ch) = w; }
    }
}

__global__ void __launch_bounds__(512, 2) mega(Params p) {
    extern __shared__ __attribute__((aligned(16))) unsigned char lds[];
    cg::grid_group grid = cg::this_grid();
    PG8_LAS unsigned char* L = (PG8_LAS unsigned char*)lds;
    const int G = gridDim.x, bx = blockIdx.x; const int tidx = pg8_tid_fresh();
    float* mod = (float*)(p.ws + WS_MOD);
    bf16_t* hA = (bf16_t*)(p.ws + WS_R);
    { float* ssq = (float*)(p.ws + WS_SSQ); for (int i = bx * NT + tidx; i < 131072; i += G * NT) ssq[i] = 0.f;
      phase_ada(p, lds);
      int g = bx, base = 0; TrJob j0{p.in[8], (bf16_t*)(p.ws + WS_WIN), 1024, 6208}, j1{p.in[15], (bf16_t*)(p.ws + WS_WOUT), 2048, 1024};
      tr_job(j0, g, base, (float*)lds); tr_job(j1, g, base, (float*)lds); }
    grid.sync();
    norm_rows(p.in[0], 16384, -1, p.in[6], mod, 0, 1024, hA);
    norm_rows(p.in[2], 2048, 8, p.in[6], mod, 0, 1024, hA + (size_t)16384 * 1024);
    grid.sync();
    { pg8::Gemm g{hA, (const bf16_t*)(p.ws + WS_WIN), 18432, 6400, 1024}; InProjOrder S; S.init(G, bx);
      EpiInProj E{(bf16_t*)p.out, (bf16_t*)(p.ws + WS_XBC), (float*)(p.ws + WS_DT)};
      pg8::gemm_phase<EpiInProj, InProjOrder, false>(L, g, S, E, nullptr); }
    grid.sync();
    phase_conv(p);
    grid.sync();
    phase_ssd(p, L);
    grid.sync();
    phase_gnorm(p);
    grid.sync();
#pragma unroll 1
    for (int l = 0; l < 2; ++l) {
        const float* modl = mod + l * 9 * 6144;
        { pg8::Gemm g{l == 0 ? (const bf16_t*)(p.ws + WS_R) : (const bf16_t*)(p.ws + WS_SCV), l == 0 ? (const bf16_t*)(p.ws + WS_WOUT) : (const bf16_t*)(p.ws + WS_SCOUT), 16384, 1024, l == 0 ? 2048 : 1024};
          pg8::StaticOrder S; S.init(16384, 1024, G, bx); EpiRes E{l == 0 ? p.in[0] : (const float*)p.out, p.out, modl + 2048};
          pg8::gemm_phase<EpiRes, pg8::StaticOrder, false>(L, g, S, E, nullptr); }
        grid.sync();
        norm_rows(p.out, 16384, -1, p.in[7] + l * 1024, modl, 3072, 4096, hA);
        if (l == 0) { int g = bx, base = 0;
            TrJob j0{p.in[19], (bf16_t*)(p.ws + WS_W1T), 1024, 4096}, j1{p.in[20], (bf16_t*)(p.ws + WS_W2T), 4096, 1024},
                  j2{p.in[16], (bf16_t*)(p.ws + WS_SCIN), 1024, 3072}, j3{p.in[19] + (size_t)1024 * 4096, (bf16_t*)(p.ws + WS_W1T) + (size_t)4096 * 1024, 1024, 4096},
                  j4{p.in[20] + (size_t)4096 * 1024, (bf16_t*)(p.ws + WS_W2T) + (size_t)1024 * 4096, 4096, 1024}, j5{p.in[18], (bf16_t*)(p.ws + WS_SCOUT), 1024, 1024};
            tr_job(j0, g, base, (float*)lds); tr_job(j1, g, base, (float*)lds); tr_job(j2, g, base, (float*)lds); tr_job(j3, g, base, (float*)lds); tr_job(j4, g, base, (float*)lds); tr_job(j5, g, base, (float*)lds); }
        grid.sync();
        { pg8::Gemm g{hA, (const bf16_t*)(p.ws + WS_W1T) + (size_t)l * 4096 * 1024, 16384, 4096, 1024}; pg8::StaticOrder S; S.init(16384, 4096, G, bx);
          EpiAct E{(bf16_t*)(p.ws + WS_U), 4096, 1}; pg8::gemm_phase<EpiAct, pg8::StaticOrder, false>(L, g, S, E, nullptr); }
        grid.sync();
        { pg8::Gemm g{(const bf16_t*)(p.ws + WS_U), (const bf16_t*)(p.ws + WS_W2T) + (size_t)l * 1024 * 4096, 16384, 1024, 4096}; pg8::StaticOrder S; S.init(16384, 1024, G, bx);
          EpiRes E{(const float*)p.out, p.out, modl + 5120}; pg8::gemm_phase<EpiRes, pg8::StaticOrder, false>(L, g, S, E, nullptr); }
        grid.sync();
        if (l == 0) {
            const float* mod1 = mod + 9 * 6144;
            norm_rows(p.out, 16384, -1, p.in[6] + 1024, mod1, 0, 1024, hA);
            grid.sync();
            { pg8::Gemm g{hA, (const bf16_t*)(p.ws + WS_SCIN), 16384, 3072, 1024}; pg8::StaticOrder S; S.init(16384, 3072, G, bx);
              EpiAct E{(bf16_t*)(p.ws + WS_SCP), 3072, 0}; pg8::gemm_phase<EpiAct, pg8::StaticOrder, false>(L, g, S, E, nullptr); }
            grid.sync();
            phase_scconv(p);
            grid.sync();
        }
    }
    final_norm(p.out, p.in[21]);
}

extern "C" void kernel_launch(void* const* d_in, const int* in_sizes, int n_in, void* d_out, int out_size, void* d_ws, size_t ws_size, hipStream_t stream) {
    static int grid_blocks = 0;
    if (!grid_blocks) {
        int dev = 0, cus = 0, per_cu = 0;
        hipGetDevice(&dev);
        hipDeviceGetAttribute(&cus, hipDeviceAttributeMultiprocessorCount, dev);
        if (hipFuncSetAttribute((const void*)mega, hipFuncAttributeMaxDynamicSharedMemorySize, LDS_BYTES) != hipSuccess) fprintf(stderr, "kernel_launch: hipFuncSetAttribute failed\n");
        hipOccupancyMaxActiveBlocksPerMultiprocessor(&per_cu, (const void*)mega, NT, LDS_BYTES);
        if (per_cu < 1) { fprintf(stderr, "kernel_launch: occupancy query says %d blocks per CU\n", per_cu); per_cu = 1; }
        grid_blocks = cus;
        if (n_in != 22 || ws_size < WS_END_A) fprintf(stderr, "kernel_launch: unexpected n_in %d / ws_size %zu\n", n_in, ws_size);
    }
    Params p{};
    for (int i = 0; i < 22; ++i) p.in[i] = (const float*)d_in[i];
    p.out = (float*)d_out; p.ws = (unsigned char*)d_ws;
    void* args[] = {&p};
    hipError_t e = hipLaunchCooperativeKernel((const void*)mega, dim3(grid_blocks), dim3(NT), args, LDS_BYTES, stream);
    if (e != hipSuccess) fprintf(stderr, "cooperative launch failed: %s (grid %d)\n", hipGetErrorString(e), grid_blocks);
}
```

```cpp
#include <hip/hip_runtime.h>
#include <hip/hip_cooperative_groups.h>
#include <cstdio>
namespace cg = cooperative_groups;
__device__ __forceinline__ int pg8_tid_fresh() { int t = threadIdx.x; asm volatile("" : "+v"(t)); return t; }
namespace pg8 {
#define PG8_LAS __attribute__((address_space(3)))
typedef unsigned short bf16_t;
typedef short bf16x8 __attribute__((ext_vector_type(8)));
typedef float f32x4 __attribute__((ext_vector_type(4)));
typedef unsigned u32x4 __attribute__((ext_vector_type(4)));
constexpr int BM = 256, BK = 64, HALF = 128, HTB = HALF * BK * 2  , STAGE_BYTES = 8 * HTB, NXCD = 8, WGM = 8;

__host__ __device__ __forceinline__ int lds_byte(int r, int c) { const int st = (r >> 4) * 2 + (c >> 5), rr = r & 15, cc = c & 31, ob = rr * 64 + cc * 2; return st * 1024 + (ob ^ (((ob >> 9) & 1) << 5)); }
__host__ __device__ __forceinline__ void stage_rc(int b, int& R, int& C) { const int st = b / 1024, sb = b % 1024, swz = sb ^ (((sb >> 9) & 1) << 5); R = (st >> 1) * 16 + swz / 64; C = (st & 1) * 32 + (swz % 64) / 2; }
__host__ __device__ __forceinline__ int perm32(int rho) { const int n = rho >> 4, i = rho & 15; return 8 * (i >> 2) + 4 * n + (i & 3); }

struct Unit { int pm, pn; };
struct Gemm { const bf16_t* A; const bf16_t* Bt; int M, N, K; };

struct StaticOrder {
    int nM, nN, nwg, G, c;
    __host__ __device__ void init(int M, int N, int G_, int c_) { nM = M / BM; nN = N / BM; nwg = nM * nN; G = G_; c = c_; }
    __host__ __device__ bool next(int i, Unit& u) const {
        const long L = (long)i * G + c; if (L >= nwg) return false;
        int wgid = (int)L; { const int q = nwg / NXCD, r = nwg % NXCD, xcd = wgid % NXCD, off = wgid / NXCD; wgid = (xcd < r ? xcd * (q + 1) : r * (q + 1) + (xcd - r) * q) + off; }
        const int nig = WGM * nN, gid = wgid / nig, fm = gid * WGM, gsz = (nM - fm) < WGM ? (nM - fm) : WGM;
        u.pm = fm + ((wgid % nig) % gsz); u.pn = (wgid % nig) / gsz; return true;
    }
    __device__ __forceinline__ void a_ready(const Unit&) const {}
    __device__ __forceinline__ void done(const Unit&) const {}
};
__device__ __forceinline__ unsigned cvt_pk_bf16(float lo, float hi) { unsigned r; asm volatile("v_cvt_pk_bf16_f32 %0, %1, %2" : "=v"(r) : "v"(lo), "v"(hi)); return r; }
template <class Epi, class Sched, bool ALIGN_EPI = false, bool SP2 = false>
__device__ __forceinline__ void gemm_phase(PG8_LAS unsigned char* lds, const Gemm g, const Sched& S, const Epi& E) {
    const int tid = pg8_tid_fresh(), wid = __builtin_amdgcn_readfirstlane(tid >> 6), lane = tid & 63, wr = wid >> 2, wc = wid & 3, fr = lane & 15, fq = lane >> 4;
    const int K = g.K, nt = K / BK;
    unsigned voffA[2], voffB[2];
#pragma unroll
    for (int i = 0; i < 2; ++i) { int R, C; stage_rc(tid * 16 + i * 8192, R, C); const int Rb = Epi::PERM ? ((R & ~31) + perm32(R & 31)) : R;
        voffA[i] = (unsigned)(R * K + C) * 2u; voffB[i] = (unsigned)(Rb * K + C) * 2u; }
    const size_t kstep = (size_t)(BK * 2);
    const size_t hstep = (size_t)HALF * K * 2;
    const size_t tstep = 2 * hstep;
    const unsigned ldsw = (unsigned)wid * 1024u;
    const int aoff = lds_byte(wr * 64 + fr, fq * 8), boff = lds_byte(wc * 32 + fr, fq * 8);
#define PG8_SA(b, h) (((b) * 2 + (h)) * HTB)
#define PG8_SB(b, h) ((4 + (b) * 2 + (h)) * HTB)
#define PG8_STAGE(bufoff, gbase, voff) do { _Pragma("unroll") for (int _i = 0; _i < 2; ++_i) \
        __builtin_amdgcn_global_load_lds((const unsigned*)((const char*)(gbase) + (voff)[_i]), (PG8_LAS unsigned*)(lds + (bufoff) + ldsw + _i * 8192), 16, 0, 0); } while (0)
#define PG8_LDA(dst, b, h) do { _Pragma("unroll") for (int m = 0; m < 4; ++m) _Pragma("unroll") for (int k = 0; k < 2; ++k) dst[m][k] = *(const PG8_LAS bf16x8*)(lds + PG8_SA(b, h) + aoff + m * 2048 + k * 1024); } while (0)
#define PG8_LDB(dst, b, h) do { _Pragma("unroll") for (int n = 0; n < 2; ++n) _Pragma("unroll") for (int k = 0; k < 2; ++k) dst[n][k] = *(const PG8_LAS bf16x8*)(lds + PG8_SB(b, h) + boff + n * 2048 + k * 1024); } while (0)
#define PG8_MMA(ai, bj, At, Bt) do { __builtin_amdgcn_s_setprio(1); _Pragma("unroll") for (int m = 0; m < 4; ++m) _Pragma("unroll") for (int n = 0; n < 2; ++n) _Pragma("unroll") for (int k = 0; k < 2; ++k) \
        acc[ai][bj][m][n] = __builtin_amdgcn_mfma_f32_16x16x32_bf16(Bt[n][k], At[m][k], acc[ai][bj][m][n], 0, 0, 0); __builtin_amdgcn_s_setprio(0); } while (0)
#define PG8_WAIT_V(n) asm volatile("s_waitcnt vmcnt(" #n ")" ::: "memory")
#define PG8_WAIT_L(n) asm volatile("s_waitcnt lgkmcnt(" #n ")" ::: "memory")
#define PG8_BAR __builtin_amdgcn_s_barrier()
#define PG8_SCHED __builtin_amdgcn_sched_barrier(0)
    Unit cur, nxt; int ui = 0;
    if (!S.next(0, cur)) return;
    f32x4 acc[2][2][4][2];
#pragma unroll
    for (int a = 0; a < 2; ++a)
#pragma unroll
        for (int b = 0; b < 2; ++b)
#pragma unroll
            for (int m = 0; m < 4; ++m)
#pragma unroll
                for (int n = 0; n < 2; ++n) acc[a][b][m][n] = (f32x4){0.f, 0.f, 0.f, 0.f};
    bf16x8 At[4][2], B0[2][2], B1[2][2];
    const char* cA = (const char*)g.A + (size_t)cur.pm * tstep; const char* cB = (const char*)g.Bt + (size_t)cur.pn * tstep;
    S.a_ready(cur);
    if constexpr (SP2) {
        PG8_STAGE(PG8_SB(0, 0), cB, voffB); PG8_STAGE(PG8_SB(0, 1), cB + hstep, voffB); PG8_STAGE(PG8_SA(0, 0), cA, voffA); PG8_STAGE(PG8_SA(0, 1), cA + hstep, voffA);
        if (wr == 1) PG8_BAR;
        PG8_WAIT_V(2); PG8_BAR;
        PG8_STAGE(PG8_SB(1, 0), cB + kstep, voffB); PG8_STAGE(PG8_SA(1, 0), cA + kstep, voffA); PG8_STAGE(PG8_SB(1, 1), cB + hstep + kstep, voffB);
        PG8_WAIT_V(6); PG8_BAR;
    } else {
        PG8_STAGE(PG8_SB(0, 0), cB, voffB); PG8_STAGE(PG8_SA(0, 0), cA, voffA); PG8_STAGE(PG8_SB(0, 1), cB + hstep, voffB); PG8_STAGE(PG8_SA(0, 1), cA + hstep, voffA);
        if (wr == 1) PG8_BAR;
        PG8_WAIT_V(4); PG8_BAR;
        PG8_STAGE(PG8_SB(1, 0), cB + kstep, voffB); PG8_STAGE(PG8_SA(1, 0), cA + kstep, voffA); PG8_STAGE(PG8_SB(1, 1), cB + hstep + kstep, voffB);
        PG8_WAIT_V(6); PG8_BAR;
    }
    for (;;) {
        const bool has_next = S.next(ui + 1, nxt);
        const char* nA = has_next ? (const char*)g.A + (size_t)nxt.pm * tstep : cA; const char* nB = has_next ? (const char*)g.Bt + (size_t)nxt.pn * tstep : cB;
        for (int t = 0; t < nt; t += 2) {
            const bool last = (t == nt - 2);
            const char* a1 = cA + (size_t)(t + 1) * kstep;
            const char* a2 = last ? nA : cA + (size_t)(t + 2) * kstep; const char* b2 = last ? nB : cB + (size_t)(t + 2) * kstep;
            const char* a3 = a2 + kstep; const char* b3 = b2 + kstep;
            if (last && has_next) S.a_ready(nxt);
            if constexpr (SP2) {
            PG8_LDB(B0, 0, 0); PG8_LDB(B1, 0, 1); PG8_SCHED; PG8_LDA(At, 0, 0); PG8_STAGE(PG8_SA(1, 1), a1 + hstep, voffA);
            PG8_WAIT_V(8); PG8_WAIT_L(0); PG8_BAR; PG8_MMA(0, 0, At, B0); PG8_MMA(0, 1, At, B1); PG8_BAR; PG8_SCHED;
            PG8_LDA(At, 0, 1); PG8_STAGE(PG8_SB(0, 0), b2, voffB); PG8_STAGE(PG8_SB(0, 1), b2 + hstep, voffB); PG8_STAGE(PG8_SA(0, 0), a2, voffA);
            PG8_WAIT_V(8); PG8_WAIT_L(0); PG8_BAR; PG8_MMA(1, 0, At, B0); PG8_MMA(1, 1, At, B1); PG8_BAR; PG8_SCHED;
            PG8_LDB(B0, 1, 0); PG8_LDB(B1, 1, 1); PG8_SCHED; PG8_LDA(At, 1, 0); PG8_STAGE(PG8_SA(0, 1), a2 + hstep, voffA);
            PG8_WAIT_V(8); PG8_WAIT_L(0); PG8_BAR; PG8_MMA(0, 0, At, B0); PG8_MMA(0, 1, At, B1); PG8_BAR; PG8_SCHED;
            PG8_LDA(At, 1, 1); PG8_STAGE(PG8_SB(1, 0), b3, voffB); PG8_STAGE(PG8_SB(1, 1), b3 + hstep, voffB); PG8_STAGE(PG8_SA(1, 0), a3, voffA);
            PG8_WAIT_V(8); PG8_WAIT_L(0); PG8_BAR; PG8_MMA(1, 0, At, B0); PG8_MMA(1, 1, At, B1); PG8_BAR; PG8_SCHED;
            } else {
            PG8_LDB(B0, 0, 0); PG8_SCHED; PG8_LDA(At, 0, 0); PG8_STAGE(PG8_SA(1, 1), a1 + hstep, voffA);
            PG8_WAIT_L(8); PG8_BAR; PG8_WAIT_L(0); PG8_MMA(0, 0, At, B0); PG8_BAR; PG8_SCHED;
            PG8_LDB(B1, 0, 1); PG8_STAGE(PG8_SB(0, 0), b2, voffB);
            PG8_BAR; PG8_WAIT_L(0); PG8_MMA(0, 1, At, B1); PG8_BAR;
            PG8_LDA(At, 0, 1); PG8_STAGE(PG8_SA(0, 0), a2, voffA);
            PG8_BAR; PG8_WAIT_L(0); PG8_MMA(1, 0, At, B0); PG8_BAR; PG8_SCHED;
            PG8_STAGE(PG8_SB(0, 1), b2 + hstep, voffB);
            PG8_WAIT_V(6); PG8_BAR; PG8_MMA(1, 1, At, B1); PG8_BAR;
            PG8_LDB(B0, 1, 0); PG8_SCHED; PG8_LDA(At, 1, 0); PG8_STAGE(PG8_SA(0, 1), a2 + hstep, voffA);
            PG8_WAIT_L(8); PG8_BAR; PG8_WAIT_L(0); PG8_MMA(0, 0, At, B0); PG8_BAR; PG8_SCHED;
            PG8_LDB(B1, 1, 1); PG8_STAGE(PG8_SB(1, 0), b3, voffB);
            PG8_BAR; PG8_WAIT_L(0); PG8_MMA(0, 1, At, B1); PG8_BAR;
            PG8_LDA(At, 1, 1); PG8_STAGE(PG8_SA(1, 0), a3, voffA);
            PG8_BAR; PG8_WAIT_L(0); PG8_MMA(1, 0, At, B0); PG8_BAR; PG8_SCHED;
            PG8_STAGE(PG8_SB(1, 1), b3 + hstep, voffB);
            PG8_WAIT_V(6); PG8_BAR; PG8_MMA(1, 1, At, B1); PG8_BAR;
            }
        }
        if constexpr (ALIGN_EPI) { if (wr == 0) PG8_BAR; }
        if constexpr (!Epi::AFTER_DRAIN) { E(acc, cur, wr, wc, fr, fq); S.done(cur); }
        if (!has_next) break;
#pragma unroll
        for (int a = 0; a < 2; ++a)
#pragma unroll
            for (int b = 0; b < 2; ++b)
#pragma unroll
                for (int m = 0; m < 4; ++m)
#pragma unroll
                    for (int n = 0; n < 2; ++n) acc[a][b][m][n] = (f32x4){0.f, 0.f, 0.f, 0.f};
        cur = nxt; cA = nA; cB = nB; ++ui;
        if constexpr (ALIGN_EPI) { if (wr == 1) PG8_BAR; }
    }
    PG8_WAIT_V(0);
    if constexpr (!ALIGN_EPI) { if (wr == 0) PG8_BAR; }
    PG8_BAR;
    if constexpr (Epi::AFTER_DRAIN) { E.fused(acc, cur, wr, wc, fr, fq, lds, wid, lane); S.done(cur); }
#undef PG8_SA
#undef PG8_SB
#undef PG8_STAGE
#undef PG8_LDA
#undef PG8_LDB
#undef PG8_MMA
#undef PG8_WAIT_V
#undef PG8_WAIT_L
#undef PG8_BAR
#undef PG8_SCHED
}
}
using pg8::bf16_t; using pg8::bf16x8; using pg8::f32x4; using pg8::u32x4; using pg8::Unit; using pg8::cvt_pk_bf16;
typedef __attribute__((address_space(3))) unsigned char* ldsp;
typedef unsigned u32x2 __attribute__((ext_vector_type(2)));
typedef short s16x4 __attribute__((ext_vector_type(4)));
typedef short v4i16_t __attribute__((ext_vector_type(4)));
#define LASQ __attribute__((address_space(3)))
#define LBAR0() asm volatile("s_waitcnt lgkmcnt(0)\n\ts_barrier" ::: "memory")

constexpr int NT = 512, LDS_BYTES = 131072 + 16 + 8192;
constexpr size_t WS_BAR = 458752;
constexpr size_t WS_MOD = 0, WS_SSQ = 524288, WS_WIN = 1048576, WS_WOUT = WS_WIN + 13107200, WS_XBC = WS_WOUT + 4194304, WS_DT = WS_XBC + 150994944,
                 WS_R = WS_DT + 4718592, WS_XBCC = WS_R + 67108864, WS_END_A = WS_XBCC + 16777216;
constexpr size_t WS_U = WS_XBC, WS_SCP = WS_XBC, WS_SCV = WS_XBC + 100663296, WS_W1T = WS_R + 33554432, WS_W2T = WS_W1T + 16777216,
                 WS_SCIN = WS_W2T + 16777216, WS_SCOUT = WS_SCIN + 6291456, WS_END_B = WS_SCOUT + 2097152;
constexpr size_t WS_SMALL2 = WS_END_A, WS_ROWSS = WS_SMALL2, WS_BW1 = WS_ROWSS + 262144, WS_BSC = WS_BW1 + 262144, WS_PCNT = WS_BSC + 98304, WS_SMALL2_END = WS_PCNT + 16384;
constexpr size_t WS_W2T0 = WS_SMALL2 + 1048576, WS_W1T0 = WS_WIN, WS_SCIN2 = WS_XBCC, WS_SCOUT2 = WS_XBCC + 6291456;
constexpr size_t WS_A1 = WS_XBC, WS_U2 = WS_XBC + 33554432, WS_A2 = WS_R + 16777216, WS_W1T1 = WS_R + 50331648, WS_W2T1 = WS_W1T1 + 8388608;
static_assert(WS_END_A <= 268435456 && WS_SMALL2_END <= WS_W2T0 && WS_W2T0 + 8388608 <= 268435456 && WS_U2 + 134217728 <= WS_A2 && WS_W2T1 + 8388608 <= WS_XBCC && WS_SCV + 33554432 <= WS_DT, "workspace map");

struct Params { const float* in[22]; float* out; unsigned char* ws; };

__device__ __forceinline__ float wave_sum(float v) {
#pragma unroll
    for (int o = 32; o >= 1; o >>= 1) v += __shfl_xor(v, o);
    return v; }
__device__ __forceinline__ float silu_f(float v) { return v * __builtin_amdgcn_rcpf(1.0f + __expf(-v)); }
__device__ __forceinline__ float softplus_f(float x) { return x > 20.f ? x : log1pf(__expf(x)); }
__device__ __forceinline__ float bf_lo(unsigned u) { return __uint_as_float(u << 16); }
__device__ __forceinline__ float bf_hi(unsigned u) { return __uint_as_float(u & 0xffff0000u); }

__device__ __forceinline__ void phase_ada(const Params& p, unsigned char* lds) {
    const int tidx = pg8_tid_fresh();
    float* s_c = (float*)lds;
    float* part = (float*)(lds + 36864);
    float* mod = (float*)(p.ws + WS_MOD);
    const int tid = tidx;
    for (int i = tid; i < 9 * 1024; i += NT) { const int b = i >> 10, k = i & 1023; const float v = b < 8 ? p.in[1][b * 1024 + k] : p.in[3][k]; s_c[i] = silu_f(v); }
    __syncthreads();
    for (int item = blockIdx.x; item < 256; item += gridDim.x) {
        const int l = item >> 7, col0 = (item & 127) * 48;
        const float* W = p.in[4] + (size_t)l * 1024 * 6144;
        if (tid < 384) {
            const int c4 = tid % 12, ks = tid / 12;
            float acc[9][4];
#pragma unroll
            for (int b = 0; b < 9; ++b)
#pragma unroll
                for (int j = 0; j < 4; ++j) acc[b][j] = 0.f;
#pragma unroll 4
            for (int kk = 0; kk < 32; ++kk) {
                const int k = ks + 32 * kk; const f32x4 w = *(const f32x4*)(W + (size_t)k * 6144 + col0 + c4 * 4);
#pragma unroll
                for (int b = 0; b < 9; ++b) { const float s = s_c[b * 1024 + k];
#pragma unroll
                    for (int j = 0; j < 4; ++j) acc[b][j] += s * w[j]; }
            }
#pragma unroll
            for (int b = 0; b < 9; ++b)
#pragma unroll
                for (int j = 0; j < 4; ++j) part[(ks * 9 + b) * 48 + c4 * 4 + j] = acc[b][j];
        }
        __syncthreads();
        if (tid < 432) { const int b = tid / 48, j = tid % 48; float s = p.in[5][l * 6144 + col0 + j];
            for (int ks = 0; ks < 32; ++ks) s += part[(ks * 9 + b) * 48 + j];
            mod[(l * 9 + b) * 6144 + col0 + j] = s; }
        __syncthreads();
    }
}
struct TrJob { const float* W; bf16_t* Wt; int K, N, ldk; };
__device__ __forceinline__ void tr_job(const TrJob& j, int& g, int& base, float* tl, const float* shv = nullptr, float* biasout = nullptr, int gstride = 0) {
    const int tidx = pg8_tid_fresh();
    const int ntn = j.N / 64, nt = (j.K / 64) * ntn, N = j.N, K = j.ldk ? j.ldk : j.K, GS = gstride ? gstride : (int)gridDim.x;
    const int r0 = tidx >> 4, c4 = tidx & 15, n = tidx >> 3, k8 = tidx & 7;
    f32x4 cur[2];
    if (g < base + nt) { const int local = g - base, tk = local / ntn, tn = local % ntn;
#pragma unroll
        for (int i = 0; i < 2; ++i) cur[i] = *(const f32x4*)(j.W + (size_t)(tk * 64 + r0 + 32 * i) * N + tn * 64 + c4 * 4); }
    while (g < base + nt) {
        const int local = g - base, tk = local / ntn, tn = local % ntn, gn = g + GS;
        f32x4 nxt[2] = {cur[0], cur[1]};
        if (gn < base + nt) { const int l2 = gn - base, tk2 = l2 / ntn, tn2 = l2 % ntn;
#pragma unroll
            for (int i = 0; i < 2; ++i) nxt[i] = *(const f32x4*)(j.W + (size_t)(tk2 * 64 + r0 + 32 * i) * N + tn2 * 64 + c4 * 4); }
#pragma unroll
        for (int i = 0; i < 2; ++i) { float* d = tl + (r0 + 32 * i) * 65 + c4 * 4; d[0] = cur[i][0]; d[1] = cur[i][1]; d[2] = cur[i][2]; d[3] = cur[i][3]; }
        LBAR0();
        { float f[8];
#pragma unroll
          for (int q = 0; q < 8; ++q) f[q] = tl[(k8 * 8 + q) * 65 + n];
          u32x4 w; w.x = cvt_pk_bf16(f[0], f[1]); w.y = cvt_pk_bf16(f[2], f[3]); w.z = cvt_pk_bf16(f[4], f[5]); w.w = cvt_pk_bf16(f[6], f[7]);
          *(u32x4*)(j.Wt + (size_t)(tn * 64 + n) * K + tk * 64 + k8 * 8) = w; }
        if (biasout) { const int bb = __builtin_amdgcn_readfirstlane(tidx >> 6), nn = tidx & 63; const float* sp = shv + bb * 6144 + tk * 64; float s = 0.f;
#pragma unroll 8
            for (int k = 0; k < 64; ++k) s += sp[k] * tl[k * 65 + nn];
            atomicAdd(biasout + (size_t)bb * N + tn * 64 + nn, s); }
        LBAR0();
        cur[0] = nxt[0]; cur[1] = nxt[1]; g = gn;
    }
    base += nt;
}

__device__ __forceinline__ void norm_rows(const float* src, int nrows, int bfix, const float* g, const float* modl, int osh, int osc, bf16_t* dst) {
    const int tidx = pg8_tid_fresh();
    const int lane = tidx & 63, wave = tidx >> 6, stride = gridDim.x * 8;
    for (int r0 = blockIdx.x * 8 + wave; r0 < nrows; r0 += 2 * stride) {
        f32x4 v[2][4]; float ss[2] = {0.f, 0.f};
#pragma unroll
        for (int u = 0; u < 2; ++u) { const int r = r0 + u * stride; if (r < nrows) {
#pragma unroll
            for (int i = 0; i < 4; ++i) v[u][i] = *(const f32x4*)(src + (size_t)r * 1024 + i * 256 + lane * 4); } else {
#pragma unroll
            for (int i = 0; i < 4; ++i) v[u][i] = (f32x4){0.f, 0.f, 0.f, 0.f}; } }
#pragma unroll
        for (int u = 0; u < 2; ++u) {
#pragma unroll
            for (int i = 0; i < 4; ++i) ss[u] += v[u][i][0] * v[u][i][0] + v[u][i][1] * v[u][i][1] + v[u][i][2] * v[u][i][2] + v[u][i][3] * v[u][i][3];
            ss[u] = wave_sum(ss[u]); }
#pragma unroll
        for (int u = 0; u < 2; ++u) { const int r = r0 + u * stride; if (r < nrows) {
            const float rstd = rsqrtf(ss[u] * (1.0f / 1024.0f) + 1e-6f);
            const int b = bfix >= 0 ? bfix : (r >> 11);
            const float* mb = modl + b * 6144;
#pragma unroll
            for (int i = 0; i < 4; ++i) { const int col = i * 256 + lane * 4; const f32x4 gg = *(const f32x4*)(g + col), sh = *(const f32x4*)(mb + osh + col), sc = *(const f32x4*)(mb + osc + col);
                const f32x4 o = (v[u][i] * rstd * gg) * (sc + 1.0f) + sh; u32x2 w; w.x = cvt_pk_bf16(o[0], o[1]); w.y = cvt_pk_bf16(o[2], o[3]);
                *(u32x2*)(dst + (size_t)r * 1024 + col) = w; } } }
    }
}
__device__ __forceinline__ void final_norm(float* x, const float* g) {
    const int tidx = pg8_tid_fresh();
    const int lane = tidx & 63, wave = tidx >> 6, stride = gridDim.x * 8;
    for (int r0 = blockIdx.x * 8 + wave; r0 < 16384; r0 += 2 * stride) {
        f32x4 v[2][4]; float ss[2] = {0.f, 0.f};
#pragma unroll
        for (int u = 0; u < 2; ++u) { const int r = r0 + u * stride; if (r < 16384) {
#pragma unroll
            for (int i = 0; i < 4; ++i) v[u][i] = *(const f32x4*)(x + (size_t)r * 1024 + i * 256 + lane * 4); } else {
#pragma unroll
            for (int i = 0; i < 4; ++i) v[u][i] = (f32x4){0.f, 0.f, 0.f, 0.f}; } }
#pragma unroll
        for (int u = 0; u < 2; ++u) {
#pragma unroll
            for (int i = 0; i < 4; ++i) ss[u] += v[u][i][0] * v[u][i][0] + v[u][i][1] * v[u][i][1] + v[u][i][2] * v[u][i][2] + v[u][i][3] * v[u][i][3];
            ss[u] = wave_sum(ss[u]); }
#pragma unroll
        for (int u = 0; u < 2; ++u) { const int r = r0 + u * stride; if (r < 16384) {
            const float rstd = rsqrtf(ss[u] * (1.0f / 1024.0f) + 1e-6f);
#pragma unroll
            for (int i = 0; i < 4; ++i) { const int col = i * 256 + lane * 4; const f32x4 gg = *(const f32x4*)(g + col); *(f32x4*)(x + (size_t)r * 1024 + col) = v[u][i] * rstd * gg; } } }
    }
}

struct InProjOrder {
    pg8::StaticOrder so; int G, c;
    __device__ __forceinline__ void init(int G_, int c_) { so.init(16384, 6400, G_, c_); G = G_; c = c_; }
    __device__ __forceinline__ bool next(int i, Unit& u) const {
        int L = i * G + c; if (L < 1600) return so.next(i, u);
        L -= 1600; if (L >= 136) return false;
        u.pm = 64 + (L & 7); u.pn = 8 + (L >> 3); return true; }
    __device__ __forceinline__ void a_ready(const Unit&) const {}
    __device__ __forceinline__ void done(const Unit&) const {}
};
struct EpiInProj {
    static constexpr bool PERM = true, AFTER_DRAIN = false;
    bf16_t* z; bf16_t* xbc; float* dt; const float* dtbias; const float* cw; const float* cb; PG8_LAS unsigned char* xch;
    __device__ __forceinline__ void operator()(const f32x4 (&acc)[2][2][4][2], const Unit& u, int wr, int wc, int fr, int fq) const {
        const int row0 = u.pm * 256 + wr * 64 + fr;
        if (u.pn == 24) {
            if (wc < 2) {
                const f32x4 b0 = *(const f32x4*)(dtbias + wc * 32 + 8 * fq), b1 = *(const f32x4*)(dtbias + wc * 32 + 8 * fq + 4);
#pragma unroll
                for (int ai = 0; ai < 2; ++ai)
#pragma unroll
                    for (int m = 0; m < 4; ++m) { float* rp = dt + (size_t)(row0 + ai * 128 + m * 16) * 64 + wc * 32 + 8 * fq; f32x4 d0 = acc[ai][0][m][0] + b0, d1 = acc[ai][0][m][1] + b1;
#pragma unroll
                        for (int j = 0; j < 4; ++j) { d0[j] = softplus_f(d0[j]); d1[j] = softplus_f(d1[j]); }
                        *(f32x4*)rp = d0; *(f32x4*)(rp + 4) = d1; }
            }
            return;
        }
        if (u.pn >= 8) {
            const int colc = (u.pn - 8) * 256 + wc * 32 + 8 * fq;
            const bool ctxt = u.pm >= 64;
            PG8_LAS float* xf = (PG8_LAS float*)xch;
            if (ctxt) {
#pragma unroll
                for (int ai = 0; ai < 2; ++ai)
#pragma unroll
                    for (int bj = 0; bj < 2; ++bj) { const int cl = (2 * ai + wr) * 256 + bj * 128 + wc * 32 + 8 * fq;
                        if (fr == 0) { *(PG8_LAS f32x4*)(xf + cl) = acc[ai][bj][0][0]; *(PG8_LAS f32x4*)(xf + cl + 4) = acc[ai][bj][0][1]; }
                        if (fr == 15) { *(PG8_LAS f32x4*)(xf + 1024 + cl) = acc[ai][bj][3][0]; *(PG8_LAS f32x4*)(xf + 1024 + cl + 4) = acc[ai][bj][3][1]; } }
                asm volatile("s_waitcnt lgkmcnt(0)" ::: "memory"); __builtin_amdgcn_s_barrier(); asm volatile("" ::: "memory");
            }
#pragma unroll
            for (int bj = 0; bj < 2; ++bj) {
                f32x4 w0[2], w1[2], w2[2], bb[2];
#pragma unroll
                for (int n = 0; n < 2; ++n) { const int c = colc + bj * 128 + 4 * n; w0[n] = *(const f32x4*)(cw + c); w1[n] = *(const f32x4*)(cw + 4096 + c); w2[n] = *(const f32x4*)(cw + 8192 + c); bb[n] = *(const f32x4*)(cb + c); }
#pragma unroll
                for (int ai = 0; ai < 2; ++ai) {
                    u32x2 pk0[4];
#pragma unroll
                    for (int n = 0; n < 2; ++n) {
                        float o[4][4];
                        f32x4 pe = (f32x4){0.f, 0.f, 0.f, 0.f}, ne = (f32x4){0.f, 0.f, 0.f, 0.f};
                        if (ctxt) { const int slab = 2 * ai + wr, cl = bj * 128 + wc * 32 + 8 * fq + 4 * n;
                            if (slab > 0) pe = *(const PG8_LAS f32x4*)(xf + 1024 + (slab - 1) * 256 + cl);
                            if (slab < 3) ne = *(const PG8_LAS f32x4*)(xf + (slab + 1) * 256 + cl); }
#pragma unroll
                        for (int j = 0; j < 4; ++j) {
                            float R0, R1, R2, R3, L0, L1, L2, L3;
                            asm("s_nop 1\n\tv_mov_b32_dpp %0, %8 row_ror:1 row_mask:0xf bank_mask:0xf\n\tv_mov_b32_dpp %1, %9 row_ror:1 row_mask:0xf bank_mask:0xf\n\t"
                                "v_mov_b32_dpp %2, %10 row_ror:1 row_mask:0xf bank_mask:0xf\n\tv_mov_b32_dpp %3, %11 row_ror:1 row_mask:0xf bank_mask:0xf\n\t"
                                "v_mov_b32_dpp %4, %8 row_ror:15 row_mask:0xf bank_mask:0xf\n\tv_mov_b32_dpp %5, %9 row_ror:15 row_mask:0xf bank_mask:0xf\n\t"
                                "v_mov_b32_dpp %6, %10 row_ror:15 row_mask:0xf bank_mask:0xf\n\tv_mov_b32_dpp %7, %11 row_ror:15 row_mask:0xf bank_mask:0xf"
                                : "=&v"(R0), "=&v"(R1), "=&v"(R2), "=&v"(R3), "=&v"(L0), "=&v"(L1), "=&v"(L2), "=&v"(L3)
                                : "v"(acc[ai][bj][0][n][j]), "v"(acc[ai][bj][1][n][j]), "v"(acc[ai][bj][2][n][j]), "v"(acc[ai][bj][3][n][j]));
                            const float Rm[5] = {pe[j], R0, R1, R2, R3}, Lm[5] = {L0, L1, L2, L3, ne[j]};
#pragma unroll
                            for (int m = 0; m < 4; ++m) {
                                const float pv = fr == 0 ? Rm[m] : Rm[m + 1], nv = fr == 15 ? Lm[m + 1] : Lm[m];
                                o[m][j] = silu_f(w0[n][j] * pv + w1[n][j] * acc[ai][bj][m][n][j] + w2[n][j] * nv + bb[n][j]); } }
#pragma unroll
                        for (int m = 0; m < 4; ++m) { u32x2 q; q.x = cvt_pk_bf16(o[m][0], o[m][1]); q.y = cvt_pk_bf16(o[m][2], o[m][3]);
                            if (n == 0) pk0[m] = q;
                            else { u32x4 w; w.x = pk0[m].x; w.y = pk0[m].y; w.z = q.x; w.w = q.y; *(u32x4*)(xbc + (size_t)(row0 + ai * 128 + m * 16) * 4096 + colc + bj * 128) = w; } }
                    }
                    asm volatile("" ::: "memory"); } }
            if (ctxt) { asm volatile("s_waitcnt lgkmcnt(0)" ::: "memory"); __builtin_amdgcn_s_barrier(); asm volatile("" ::: "memory"); }
            return;
        }
        bf16_t* base; int ldc, colt;
        if (u.pn < 8) { base = z; ldc = 2048; colt = u.pn * 256; } else { base = xbc; ldc = 4096; colt = (u.pn - 8) * 256; }
        const int col0 = colt + wc * 32 + 8 * fq;
#pragma unroll
        for (int ai = 0; ai < 2; ++ai)
#pragma unroll
            for (int m = 0; m < 4; ++m) { bf16_t* rowp = base + (size_t)(row0 + ai * 128 + m * 16) * ldc + col0;
#pragma unroll
                for (int bj = 0; bj < 2; ++bj) { const f32x4 v0 = acc[ai][bj][m][0], v1 = acc[ai][bj][m][1];
                    u32x4 w; w.x = cvt_pk_bf16(v0[0], v0[1]); w.y = cvt_pk_bf16(v0[2], v0[3]); w.z = cvt_pk_bf16(v1[0], v1[1]); w.w = cvt_pk_bf16(v1[2], v1[3]);
                    *(u32x4*)(rowp + bj * 128) = w; } }
    }
};
struct EpiAct {
    static constexpr bool PERM = true, AFTER_DRAIN = false;
    bf16_t* O; int ldc; int act; const float* rowss; const float* bias;
    __device__ __forceinline__ void operator()(const f32x4 (&acc)[2][2][4][2], const Unit& u, int wr, int wc, int fr, int fq) const {
        const int row0 = u.pm * 256 + wr * 64 + fr, col0 = u.pn * 256 + wc * 32 + 8 * fq, b = u.pm >> 3;
        f32x4 bv[2][2];
#pragma unroll
        for (int bj = 0; bj < 2; ++bj)
#pragma unroll
            for (int n = 0; n < 2; ++n) bv[bj][n] = *(const f32x4*)(bias + (size_t)b * ldc + col0 + bj * 128 + 4 * n);
#pragma unroll
        for (int ai = 0; ai < 2; ++ai)
#pragma unroll
            for (int m = 0; m < 4; ++m) { const int row = row0 + ai * 128 + m * 16; bf16_t* rowp = O + (size_t)row * ldc + col0;
                const float rs = rsqrtf(rowss[row] * (1.0f / 1024.0f) + 1e-6f);
#pragma unroll
                for (int bj = 0; bj < 2; ++bj) { f32x4 v0 = acc[ai][bj][m][0] * rs + bv[bj][0], v1 = acc[ai][bj][m][1] * rs + bv[bj][1];
                    if (act) {
#pragma unroll
                        for (int j = 0; j < 4; ++j) { const float a = fmaxf(v0[j], 0.f), c = fmaxf(v1[j], 0.f); v0[j] = a * a; v1[j] = c * c; } }
                    u32x4 w; w.x = cvt_pk_bf16(v0[0], v0[1]); w.y = cvt_pk_bf16(v0[2], v0[3]); w.z = cvt_pk_bf16(v1[0], v1[1]); w.w = cvt_pk_bf16(v1[2], v1[3]);
                    *(u32x4*)(rowp + bj * 128) = w; } }
    }
};
struct EpiRes {
    static constexpr bool PERM = true, AFTER_DRAIN = false;
    const float* xin32; const bf16_t* xinbf; bf16_t* xout; const float* gate; bf16_t* abf; const float* ng; const float* sc; float* rowss;
    __device__ __forceinline__ void operator()(const f32x4 (&acc)[2][2][4][2], const Unit& u, int wr, int wc, int fr, int fq) const {
        const int row0 = u.pm * 256 + wr * 64 + fr, col0 = u.pn * 256 + wc * 32 + 8 * fq, b = u.pm >> 3;
        f32x4 gv[2][2], sv[2][2];
#pragma unroll
        for (int bj = 0; bj < 2; ++bj)
#pragma unroll
            for (int n = 0; n < 2; ++n) { gv[bj][n] = *(const f32x4*)(gate + b * 6144 + col0 + bj * 128 + 4 * n);
                sv[bj][n] = *(const f32x4*)(ng + col0 + bj * 128 + 4 * n) * (*(const f32x4*)(sc + b * 6144 + col0 + bj * 128 + 4 * n) + 1.0f); }
#pragma unroll
        for (int ai = 0; ai < 2; ++ai)
#pragma unroll
            for (int m = 0; m < 4; ++m) { const int row = row0 + ai * 128 + m * 16; const size_t off = (size_t)row * 1024 + col0; float ss = 0.f;
#pragma unroll
                for (int bj = 0; bj < 2; ++bj) { f32x4 x0, x1;
                    if (xin32) { x0 = *(const f32x4*)(xin32 + off + bj * 128); x1 = *(const f32x4*)(xin32 + off + bj * 128 + 4); }
                    else { const u32x4 r = *(const u32x4*)(xinbf + off + bj * 128); x0 = (f32x4){bf_lo(r.x), bf_hi(r.x), bf_lo(r.y), bf_hi(r.y)}; x1 = (f32x4){bf_lo(r.z), bf_hi(r.z), bf_lo(r.w), bf_hi(r.w)}; }
                    const f32x4 xo0 = x0 + gv[bj][0] * acc[ai][bj][m][0], xo1 = x1 + gv[bj][1] * acc[ai][bj][m][1];
                    u32x4 xr; xr.x = cvt_pk_bf16(xo0[0], xo0[1]); xr.y = cvt_pk_bf16(xo0[2], xo0[3]); xr.z = cvt_pk_bf16(xo1[0], xo1[1]); xr.w = cvt_pk_bf16(xo1[2], xo1[3]);
                    *(u32x4*)(xout + off + bj * 128) = xr;
                    ss += xo0[0] * xo0[0] + xo0[1] * xo0[1] + xo0[2] * xo0[2] + xo0[3] * xo0[3] + xo1[0] * xo1[0] + xo1[1] * xo1[1] + xo1[2] * xo1[2] + xo1[3] * xo1[3];
                    const f32x4 a0 = xo0 * sv[bj][0], a1 = xo1 * sv[bj][1];
                    u32x4 w; w.x = cvt_pk_bf16(a0[0], a0[1]); w.y = cvt_pk_bf16(a0[2], a0[3]); w.z = cvt_pk_bf16(a1[0], a1[1]); w.w = cvt_pk_bf16(a1[2], a1[3]); *(u32x4*)(abf + off + bj * 128) = w; }
                ss += __shfl_xor(ss, 16); ss += __shfl_xor(ss, 32); if (fq == 0) atomicAdd(rowss + row, ss);
                asm volatile("" ::: "memory"); }
    }
};

struct EpiResFin {
    static constexpr bool PERM = true, AFTER_DRAIN = true;
    const bf16_t* xinbf; float* out; const float* gate; float* rowss; const float* fin; unsigned* pcnt;
    __device__ __forceinline__ void fused(f32x4 (&acc)[2][2][4][2], const Unit& u, int wr, int wc, int fr, int fq, PG8_LAS unsigned char*, int, int) const {
        const int row0 = u.pm * 256 + wr * 64 + fr, col0 = u.pn * 256 + wc * 32 + 8 * fq, b = u.pm >> 3;
        f32x4 gv[2][2], sv[2][2];
#pragma unroll
        for (int bj = 0; bj < 2; ++bj)
#pragma unroll
            for (int n = 0; n < 2; ++n) { gv[bj][n] = *(const f32x4*)(gate + b * 6144 + col0 + bj * 128 + 4 * n); sv[bj][n] = *(const f32x4*)(fin + col0 + bj * 128 + 4 * n); }
#pragma unroll
        for (int ai = 0; ai < 2; ++ai)
#pragma unroll
            for (int m = 0; m < 4; ++m) { const int row = row0 + ai * 128 + m * 16; const size_t off = (size_t)row * 1024 + col0; float ss = 0.f;
#pragma unroll
                for (int bj = 0; bj < 2; ++bj) { const u32x4 r = *(const u32x4*)(xinbf + off + bj * 128);
                    const f32x4 xo0 = (f32x4){bf_lo(r.x), bf_hi(r.x), bf_lo(r.y), bf_hi(r.y)} + gv[bj][0] * acc[ai][bj][m][0], xo1 = (f32x4){bf_lo(r.z), bf_hi(r.z), bf_lo(r.w), bf_hi(r.w)} + gv[bj][1] * acc[ai][bj][m][1];
                    acc[ai][bj][m][0] = xo0; acc[ai][bj][m][1] = xo1;
                    ss += xo0[0] * xo0[0] + xo0[1] * xo0[1] + xo0[2] * xo0[2] + xo0[3] * xo0[3] + xo1[0] * xo1[0] + xo1[1] * xo1[1] + xo1[2] * xo1[2] + xo1[3] * xo1[3]; }
                ss += __shfl_xor(ss, 16); ss += __shfl_xor(ss, 32); if (fq == 0) atomicAdd(rowss + row, ss);
                asm volatile("" ::: "memory"); }
        asm volatile("s_waitcnt vmcnt(0)" ::: "memory");
        unsigned* cw = pcnt + 64 * u.pm;
        if (fr == 0 && fq == 0) (void)__hip_atomic_fetch_add(cw, 1u, __ATOMIC_RELAXED, __HIP_MEMORY_SCOPE_AGENT);
        { unsigned polls = 0u; while (__hip_atomic_load(cw, __ATOMIC_RELAXED, __HIP_MEMORY_SCOPE_AGENT) < 32u && ++polls < (1u << 18)) __builtin_amdgcn_s_sleep(2); }
#pragma unroll
        for (int ai = 0; ai < 2; ++ai)
#pragma unroll
            for (int m = 0; m < 4; ++m) { const int row = row0 + ai * 128 + m * 16; const size_t off = (size_t)row * 1024 + col0;
                const float rs = rsqrtf(__hip_atomic_load(rowss + row, __ATOMIC_RELAXED, __HIP_MEMORY_SCOPE_AGENT) * (1.0f / 1024.0f) + 1e-6f);
#pragma unroll
                for (int bj = 0; bj < 2; ++bj)
#pragma unroll
                    for (int n = 0; n < 2; ++n) *(f32x4*)(out + off + bj * 128 + 4 * n) = acc[ai][bj][m][n] * rs * sv[bj][n]; }
    }
};

__device__ __forceinline__ void unpack8(const u32x4 v, float (&f)[8]) { f[0] = bf_lo(v.x); f[1] = bf_hi(v.x); f[2] = bf_lo(v.y); f[3] = bf_hi(v.y); f[4] = bf_lo(v.z); f[5] = bf_hi(v.z); f[6] = bf_lo(v.w); f[7] = bf_hi(v.w); }
__device__ __forceinline__ void phase_conv(const Params& p) {
    const int tidx = pg8_tid_fresh();
    const int lane = tidx & 63, wave = tidx >> 6;
    bf16_t* xbc = (bf16_t*)(p.ws + WS_XBC); bf16_t* xbcc = (bf16_t*)(p.ws + WS_XBCC);
    const float* cw = p.in[9]; const float* cb = p.in[10];
    for (int item0 = wave * gridDim.x + blockIdx.x; item0 < 256; item0 += gridDim.x * 8) {
        const int item = item0 + 2048; const int seg = item >> 3, slab = item & 7, ch = slab * 512 + lane * 8;
        const bf16_t* src; bf16_t* dst; bool has_prev = false, has_next = false;
        if (seg < 256) { src = xbc + (size_t)seg * 64 * 4096 + ch; dst = xbc + (size_t)seg * 64 * 4096 + ch; }
        else { const int cs = seg - 256, q = cs & 3; src = xbc + (size_t)(16384 + cs * 64) * 4096 + ch; dst = xbcc + (size_t)cs * 64 * 4096 + ch; has_prev = q > 0; has_next = q < 3; }
        float w0[8], w1[8], w2[8], bb[8];
#pragma unroll
        for (int h = 0; h < 2; ++h) { const f32x4 a = *(const f32x4*)(cw + ch + 4 * h), b = *(const f32x4*)(cw + 4096 + ch + 4 * h), c = *(const f32x4*)(cw + 8192 + ch + 4 * h), d = *(const f32x4*)(cb + ch + 4 * h);
#pragma unroll
            for (int j = 0; j < 4; ++j) { w0[4 * h + j] = a[j]; w1[4 * h + j] = b[j]; w2[4 * h + j] = c[j]; bb[4 * h + j] = d[j]; } }
        u32x4 prev = (u32x4){0u, 0u, 0u, 0u};
        if (has_prev) prev = *(const u32x4*)(src - 4096);
        for (int sb = 0; sb < 4; ++sb) {
            u32x4 r[16];
#pragma unroll
            for (int i = 0; i < 16; ++i) r[i] = *(const u32x4*)(src + (size_t)(sb * 16 + i) * 4096);
            u32x4 nxt = (u32x4){0u, 0u, 0u, 0u};
            if (sb < 3 || has_next) nxt = *(const u32x4*)(src + (size_t)(sb * 16 + 16) * 4096);
            float fp[8], fc[8], fn[8];
            unpack8(prev, fp); unpack8(r[0], fc);
#pragma unroll
            for (int i = 0; i < 16; ++i) {
                unpack8(i < 15 ? r[i < 15 ? i + 1 : 15] : nxt, fn);
                float o[8];
#pragma unroll
                for (int j = 0; j < 8; ++j) { o[j] = silu_f(w0[j] * fp[j] + w1[j] * fc[j] + w2[j] * fn[j] + bb[j]); fp[j] = fc[j]; fc[j] = fn[j]; }
                u32x4 w; w.x = cvt_pk_bf16(o[0], o[1]); w.y = cvt_pk_bf16(o[2], o[3]); w.z = cvt_pk_bf16(o[4], o[5]); w.w = cvt_pk_bf16(o[6], o[7]);
                *(u32x4*)(dst + (size_t)(sb * 16 + i) * 4096) = w;
            }
            prev = r[15];
        }
    }
}

__device__ __forceinline__ bf16x8 ld_frag(ldsp L, int off) { return *(const LASQ bf16x8*)(L + off); }
__device__ __forceinline__ s16x4 tr4(ldsp L, int off) { return __builtin_bit_cast(s16x4, __builtin_amdgcn_ds_read_tr16_b64_v4i16((LASQ v4i16_t*)(L + off))); }
__device__ __forceinline__ bf16x8 tr_frag(ldsp L, int off, int stride) { const s16x4 a = tr4(L, off), b = tr4(L, off + 4 * stride); return (bf16x8){a[0], a[1], a[2], a[3], b[0], b[1], b[2], b[3]}; }
__device__ __forceinline__ unsigned scale2(unsigned u, float s0, float s1) { return cvt_pk_bf16(bf_lo(u) * s0, bf_hi(u) * s1); }
#define LBAR() asm volatile("s_waitcnt lgkmcnt(0)\n\ts_barrier" ::: "memory")
#define MFMA16(a, b, c) __builtin_amdgcn_mfma_f32_16x16x32_bf16((a), (b), (c), 0, 0, 0)

__device__ __forceinline__ void phase_ssd(const Params& p, ldsp L) {
    const int tidx = pg8_tid_fresh();
    constexpr int RS = 272, RSX = 144, CN = 0, BN = 34816, XS = 69632, HB = 88064, CSO = 105472, WO = 105984, TOTO = 106496, CSD = 106512;
    const int tid = tidx, lane = tid & 63, w = __builtin_amdgcn_readfirstlane(tid >> 6), fr = lane & 15, fq = lane >> 4, q4 = fr >> 2, p4 = fr & 3;
    const bf16_t* xbc = (const bf16_t*)(p.ws + WS_XBC); const bf16_t* xbcc = (const bf16_t*)(p.ws + WS_XBCC);
    const float* dtb = (const float*)(p.ws + WS_DT); bf16_t* yb = (bf16_t*)(p.ws + WS_R);
    LASQ float* csf = (LASQ float*)(L + CSO); LASQ float* wf = (LASQ float*)(L + WO); LASQ float* totf = (LASQ float*)(L + TOTO); LASQ float* csd = (LASQ float*)(L + CSD);
    const int pw = w & 3, nb0 = (w >> 2) * 4;
    const int tb = w < 4 ? w : 11 - w;
    const int trow = 16 * tb + fr;
    const int xrow0 = tid >> 3, xpc = tid & 7, brow0 = tid >> 4, bpc = tid & 15;
    for (int it = blockIdx.x; it < 256; it += gridDim.x) {
        const int xcd = it & 7, slot = it >> 3, pgi = xcd * 8 + (slot >> 2), r = slot & 3, b = pgi >> 3, g = pgi & 7, head = g * 4 + r;
        const float Dh = p.in[13][head];
        f32x4 hacc[4];
        u32x4 px[2], pb[4], pc[4]; float pa0 = 0.f, pa1 = 0.f;
        const unsigned vX0 = (unsigned)(xrow0 * 4096 + head * 64 + xpc * 8), vB0 = (unsigned)(brow0 * 4096 + 2048 + g * 128 + bpc * 8), vD0 = (unsigned)(lane * 64);
        const unsigned vY = (unsigned)(trow * 2048 + head * 64 + 8 * fq);
#define SSD_PREFETCH(sidx_) do { const int dir_ = (sidx_) >= 18 ? 1 : 0, step_ = (sidx_) - 18 * dir_; const bool isctx_ = step_ < 2; \
            const int c_ = isctx_ ? (dir_ ? 1 - step_ : step_) : (dir_ ? 17 - step_ : step_ - 2); \
            const bf16_t* src_ = isctx_ ? xbc + (size_t)(16384 + b * 256 + c_ * 128) * 4096 : xbc + (size_t)(b * 2048 + c_ * 128) * 4096; \
            const int grow_ = isctx_ ? 16384 + b * 256 + c_ * 128 : b * 2048 + c_ * 128; \
            const float* dtp_ = dtb + (size_t)grow_ * 64 + dir_ * 32 + head; \
            _Pragma("unroll") for (int i = 0; i < 2; ++i) px[i] = *(const u32x4*)(src_ + (vX0 + (unsigned)(i * 64 * 4096))); \
            _Pragma("unroll") for (int i = 0; i < 4; ++i) { pb[i] = *(const u32x4*)(src_ + (vB0 + (unsigned)(i * 32 * 4096))); pc[i] = *(const u32x4*)(src_ + (vB0 + (unsigned)(i * 32 * 4096 + 1024))); } \
            if (w == 0) { pa0 = dtp_[vD0]; pa1 = dtp_[vD0 + 4096u]; } } while (0)
        SSD_PREFETCH(0);
        float A = 0.f;
#pragma unroll 1
        for (int sidx = 0; sidx < 36; ++sidx) {
            const int dir = sidx >= 18 ? 1 : 0, step = sidx - 18 * dir;
            if (step == 0) { A = -__expf(p.in[12][dir * 32 + head]);
#pragma unroll
                for (int i = 0; i < 4; ++i) hacc[i] = (f32x4){0.f, 0.f, 0.f, 0.f}; }
            const bool isctx = step < 2;
            const int c = isctx ? (dir ? 1 - step : step) : (dir ? 17 - step : step - 2);
            const int grow0 = isctx ? 16384 + b * 256 + c * 128 : b * 2048 + c * 128;
#pragma unroll
            for (int i = 0; i < 2; ++i) { const int row = xrow0 + 64 * i; u32x2 lo, hi; lo.x = px[i].x; lo.y = px[i].y; hi.x = px[i].z; hi.y = px[i].w;
                *(LASQ u32x2*)(L + XS + row * RSX + (32 * (xpc >> 2) + 4 * (xpc & 3)) * 2) = lo; *(LASQ u32x2*)(L + XS + row * RSX + (32 * (xpc >> 2) + 16 + 4 * (xpc & 3)) * 2) = hi; }
#pragma unroll
            for (int i = 0; i < 4; ++i) { const int row = brow0 + 32 * i; *(LASQ u32x4*)(L + BN + row * RS + bpc * 16) = pb[i]; *(LASQ u32x4*)(L + CN + row * RS + bpc * 16) = pc[i]; }
            if (!isctx) {
#pragma unroll
                for (int i = 0; i < 4; ++i) { u32x2 hw; hw.x = cvt_pk_bf16(hacc[i][0], hacc[i][1]); hw.y = cvt_pk_bf16(hacc[i][2], hacc[i][3]);
                    *(LASQ u32x2*)(L + HB + (16 * pw + fr) * RS + (16 * (nb0 + i) + 4 * fq) * 2) = hw; }
            }
            if (w == 0) {
                const float a0 = pa0 * A * 1.44269504089f, a1 = pa1 * A * 1.44269504089f;
                float p0 = a0, p1 = a1;
#pragma unroll
                for (int o = 1; o < 64; o <<= 1) { const float t0 = __shfl_up(p0, o), t1 = __shfl_up(p1, o); if (lane >= o) { p0 += t0; p1 += t1; } }
                p1 += __shfl(p0, 63);
                const float total = __shfl(p1, 63);
                if (dir) { p0 = total - p0 + a0; p1 = total - p1 + a1; }
                csf[lane] = p0; csf[64 + lane] = p1; csd[lane] = p0 - __builtin_amdgcn_logf(pa0); csd[64 + lane] = p1 - __builtin_amdgcn_logf(pa1);
                wf[lane] = __builtin_amdgcn_exp2f(total - p0) * pa0; wf[64 + lane] = __builtin_amdgcn_exp2f(total - p1) * pa1;
                if (lane == 0) totf[0] = total;
            }
            if (sidx + 1 < 36) SSD_PREFETCH(sidx + 1);
            bf16_t* ybase = yb + (size_t)grow0 * 2048;
            u32x4 pv[2];
            if (!isctx && dir == 1) {
#pragma unroll
                for (int q = 0; q < 2; ++q) pv[q] = *(const u32x4*)(ybase + (vY + 32u * q));
            }
            LBAR0();
            const float total = totf[0];
            if (!isctx) {
                const float cst = csf[trow];
                bf16x8 cf[4];
#pragma unroll
                for (int ks = 0; ks < 4; ++ks) cf[ks] = ld_frag(L, CN + trow * RS + ks * 64 + fq * 16);
                f32x4 yacc[4];
#pragma unroll
                for (int pt = 0; pt < 4; ++pt) { yacc[pt] = (f32x4){0.f, 0.f, 0.f, 0.f};
#pragma unroll
                    for (int ks = 0; ks < 4; ++ks) { const bf16x8 hf = ld_frag(L, HB + (16 * pt + fr) * RS + ks * 64 + fq * 16); yacc[pt] = MFMA16(hf, cf[ks], yacc[pt]); } }
                const float ect = __builtin_amdgcn_exp2f(cst);
#pragma unroll
                for (int pt = 0; pt < 4; ++pt) yacc[pt] *= ect;
                const int ks_lo = dir ? (tb >> 1) : 0, ks_hi = dir ? 3 : (tb >> 1);
#pragma unroll 1
                for (int kp = ks_lo; kp <= ks_hi; ++kp) {
                    f32x4 s0 = (f32x4){0.f, 0.f, 0.f, 0.f}, s1 = (f32x4){0.f, 0.f, 0.f, 0.f};
#pragma unroll
                    for (int ks = 0; ks < 4; ++ks) { const bf16x8 b0 = ld_frag(L, BN + (32 * kp + fr) * RS + ks * 64 + fq * 16), b1 = ld_frag(L, BN + (32 * kp + 16 + fr) * RS + ks * 64 + fq * 16);
                        s0 = MFMA16(b0, cf[ks], s0); s1 = MFMA16(b1, cf[ks], s1); }
                    s16x4 xa[4], xb[4];
#pragma unroll
                    for (int pt = 0; pt < 4; ++pt) { xa[pt] = tr4(L, XS + (32 * kp + 4 * fq + q4) * RSX + 32 * pt + 8 * p4); xb[pt] = tr4(L, XS + (32 * kp + 16 + 4 * fq + q4) * RSX + 32 * pt + 8 * p4); }
                    const f32x4 c0 = *(const LASQ f32x4*)(L + CSD + (32 * kp + 4 * fq) * 4), c1 = *(const LASQ f32x4*)(L + CSD + (32 * kp + 16 + 4 * fq) * 4);
                    float l0[4], l1[4];
#pragma unroll
                    for (int j = 0; j < 4; ++j) { const int si = 32 * kp + 4 * fq + j; const bool ok0 = dir ? (si >= trow) : (si <= trow), ok1 = dir ? (si + 16 >= trow) : (si + 16 <= trow);
                        l0[j] = ok0 ? s0[j] * __builtin_amdgcn_exp2f(cst - c0[j]) : 0.f; l1[j] = ok1 ? s1[j] * __builtin_amdgcn_exp2f(cst - c1[j]) : 0.f; }
                    u32x4 lu; lu.x = cvt_pk_bf16(l0[0], l0[1]); lu.y = cvt_pk_bf16(l0[2], l0[3]); lu.z = cvt_pk_bf16(l1[0], l1[1]); lu.w = cvt_pk_bf16(l1[2], l1[3]);
                    const bf16x8 lf = __builtin_bit_cast(bf16x8, lu);
#pragma unroll
                    for (int pt = 0; pt < 4; ++pt) { const bf16x8 xf = (bf16x8){xa[pt][0], xa[pt][1], xa[pt][2], xa[pt][3], xb[pt][0], xb[pt][1], xb[pt][2], xb[pt][3]}; yacc[pt] = MFMA16(xf, lf, yacc[pt]); }
                }
                if (dir == 0) {
#pragma unroll
                    for (int q = 0; q < 2; ++q) { u32x4 o; o.x = cvt_pk_bf16(yacc[2 * q][0], yacc[2 * q][1]); o.y = cvt_pk_bf16(yacc[2 * q][2], yacc[2 * q][3]);
                        o.z = cvt_pk_bf16(yacc[2 * q + 1][0], yacc[2 * q + 1][1]); o.w = cvt_pk_bf16(yacc[2 * q + 1][2], yacc[2 * q + 1][3]);
                        *(u32x4*)(ybase + (vY + 32u * q)) = o; }
                } else {
#pragma unroll
                    for (int q = 0; q < 2; ++q) {
                        const u32x2 xa = *(const LASQ u32x2*)(L + XS + trow * RSX + (32 * q + 4 * fq) * 2), xb = *(const LASQ u32x2*)(L + XS + trow * RSX + (32 * q + 16 + 4 * fq) * 2);
                        u32x4 o;
                        o.x = cvt_pk_bf16(yacc[2 * q][0] + bf_lo(pv[q].x) + Dh * bf_lo(xa.x), yacc[2 * q][1] + bf_hi(pv[q].x) + Dh * bf_hi(xa.x));
                        o.y = cvt_pk_bf16(yacc[2 * q][2] + bf_lo(pv[q].y) + Dh * bf_lo(xa.y), yacc[2 * q][3] + bf_hi(pv[q].y) + Dh * bf_hi(xa.y));
                        o.z = cvt_pk_bf16(yacc[2 * q + 1][0] + bf_lo(pv[q].z) + Dh * bf_lo(xb.x), yacc[2 * q + 1][1] + bf_hi(pv[q].z) + Dh * bf_hi(xb.x));
                        o.w = cvt_pk_bf16(yacc[2 * q + 1][2] + bf_lo(pv[q].w) + Dh * bf_lo(xb.y), yacc[2 * q + 1][3] + bf_hi(pv[q].w) + Dh * bf_hi(xb.y));
                        *(u32x4*)(ybase + (vY + 32u * q)) = o; }
                }
            }
            { const float et = __builtin_amdgcn_exp2f(total);
#pragma unroll
              for (int i = 0; i < 4; ++i) hacc[i] *= et;
#pragma unroll
              for (int ks = 0; ks < 4; ++ks) {
                  const bf16x8 xr = tr_frag(L, XS + (32 * ks + 8 * fq + q4) * RSX + 32 * pw + 8 * p4, RSX);
                  const f32x4 wa = *(const LASQ f32x4*)(L + WO + (32 * ks + 8 * fq) * 4), wb = *(const LASQ f32x4*)(L + WO + (32 * ks + 8 * fq + 4) * 4);
                  const u32x4 xu = __builtin_bit_cast(u32x4, xr); u32x4 xs;
                  xs.x = scale2(xu.x, wa[0], wa[1]); xs.y = scale2(xu.y, wa[2], wa[3]); xs.z = scale2(xu.z, wb[0], wb[1]); xs.w = scale2(xu.w, wb[2], wb[3]);
                  const bf16x8 xsf = __builtin_bit_cast(bf16x8, xs);
#pragma unroll
                  for (int i = 0; i < 4; ++i) { const bf16x8 bfr = tr_frag(L, BN + (32 * ks + 8 * fq + q4) * RS + 32 * (nb0 + i) + 8 * p4, RS); hacc[i] = MFMA16(bfr, xsf, hacc[i]); } } }
            LBAR0();
        }
#undef SSD_PREFETCH
    }
}

__device__ __forceinline__ void phase_gnorm(const Params& p) {
    const int tidx = pg8_tid_fresh();
    const int lane = tidx & 63, wave = tidx >> 6, stride = gridDim.x * 8;
    bf16_t* yb = (bf16_t*)(p.ws + WS_R); const bf16_t* zb = (const bf16_t*)p.out; const float* ng = p.in[14];
    for (int r0 = blockIdx.x * 8 + wave; r0 < 16384; r0 += 2 * stride) {
        u32x4 v[2][4], zz[2][4];
#pragma unroll
        for (int u = 0; u < 2; ++u) { const int r = r0 + u * stride < 16384 ? r0 + u * stride : r0;
#pragma unroll
            for (int i = 0; i < 4; ++i) { const int col = i * 512 + lane * 8; v[u][i] = *(const u32x4*)(yb + (size_t)r * 2048 + col); zz[u][i] = *(const u32x4*)(zb + (size_t)r * 2048 + col); } }
#pragma unroll
        for (int u = 0; u < 2; ++u) { const int r = r0 + u * stride;
#pragma unroll
            for (int i = 0; i < 4; ++i) { const int col = i * 512 + lane * 8; float y[8], z[8]; unpack8(v[u][i], y); unpack8(zz[u][i], z); float sq = 0.f;
#pragma unroll
                for (int j = 0; j < 8; ++j) { y[j] *= silu_f(z[j]); sq += y[j] * y[j]; }
                sq += __shfl_xor(sq, 16); sq += __shfl_xor(sq, 8); sq += __shfl_xor(sq, 4); sq += __shfl_xor(sq, 2); sq += __shfl_xor(sq, 1);
                const float s = rsqrtf(sq * (1.0f / 256.0f) + 1e-6f);
                const f32x4 g0 = *(const f32x4*)(ng + col), g1 = *(const f32x4*)(ng + col + 4); u32x4 o;
                o.x = cvt_pk_bf16((y[0] * s) * g0[0], (y[1] * s) * g0[1]); o.y = cvt_pk_bf16((y[2] * s) * g0[2], (y[3] * s) * g0[3]);
                o.z = cvt_pk_bf16((y[4] * s) * g1[0], (y[5] * s) * g1[1]); o.w = cvt_pk_bf16((y[6] * s) * g1[2], (y[7] * s) * g1[3]);
                if (r < 16384) *(u32x4*)(yb + (size_t)r * 2048 + col) = o; } }
    }
}

__device__ __forceinline__ void phase_scconv(const Params& p) {
    const int tidx = pg8_tid_fresh();
    const int lane = tidx & 63, wave = tidx >> 6;
    const bf16_t* P = (const bf16_t*)(p.ws + WS_SCP); bf16_t* V = (bf16_t*)(p.ws + WS_SCV); const float* cw = p.in[17];
    for (int item = blockIdx.x * 8 + wave; item < 8192; item += gridDim.x * 8) {
        const int rb = item >> 1, half = item & 1, ch = half * 512 + lane * 8, t0 = rb * 4, tin = t0 & 63;
        float w0[8], w1[8], w2[8];
#pragma unroll
        for (int h = 0; h < 2; ++h) { const f32x4 a = *(const f32x4*)(cw + ch + 4 * h), b = *(const f32x4*)(cw + 1024 + ch + 4 * h), c = *(const f32x4*)(cw + 2048 + ch + 4 * h);
#pragma unroll
            for (int j = 0; j < 4; ++j) { w0[4 * h + j] = a[j]; w1[4 * h + j] = b[j]; w2[4 * h + j] = c[j]; } }
        float m[6][8];
#pragma unroll
        for (int i = 0; i < 6; ++i) { const int t = t0 - 1 + i; const bool ok = !((i == 0 && tin == 0) || (i == 5 && tin == 60));
            if (ok) { const u32x4 cg = *(const u32x4*)(P + (size_t)t * 3072 + 1024 + ch), xv = *(const u32x4*)(P + (size_t)t * 3072 + 2048 + ch); float a[8], b[8]; unpack8(cg, a); unpack8(xv, b);
#pragma unroll
                for (int j = 0; j < 8; ++j) m[i][j] = a[j] * b[j]; }
            else {
#pragma unroll
                for (int j = 0; j < 8; ++j) m[i][j] = 0.f; } }
#pragma unroll
        for (int i = 0; i < 4; ++i) { const u32x4 bg = *(const u32x4*)(P + (size_t)(t0 + i) * 3072 + ch); float bgf[8], o[8]; unpack8(bg, bgf);
#pragma unroll
            for (int j = 0; j < 8; ++j) o[j] = bgf[j] * (w0[j] * m[i][j] + w1[j] * m[i + 1][j] + w2[j] * m[i + 2][j]);
            u32x4 w; w.x = cvt_pk_bf16(o[0], o[1]); w.y = cvt_pk_bf16(o[2], o[3]); w.z = cvt_pk_bf16(o[4], o[5]); w.w = cvt_pk_bf16(o[6], o[7]);
            *(u32x4*)(V + (size_t)(t0 + i) * 1024 + ch) = w; }
    }
}


#define XB_TMO      128
#define XB_XCNT(j)  (256  + 64 * (j))
#define XB_XSUB(j)  (1280 + 64 * (j))
#define XB_XGEN(j)  (2304 + 64 * (j))
#define XB_TOP      3328
#define XB_TOPGEN   3392
#define XCD_BAR_WORDS 3456
#define XB_SPIN_CAP (1u << 18)
__device__ __forceinline__ unsigned xb_ld(unsigned* p)              { return __hip_atomic_load(p, __ATOMIC_RELAXED, __HIP_MEMORY_SCOPE_AGENT); }
__device__ __forceinline__ unsigned xb_add(unsigned* p, unsigned v) { return __hip_atomic_fetch_add(p, v, __ATOMIC_RELAXED, __HIP_MEMORY_SCOPE_AGENT); }
__device__ __forceinline__ unsigned xb_xcc_id() { return (unsigned)__builtin_amdgcn_s_getreg((3 << 11) | 20) & 0xFu; }
#define XB_SPIN(cond, bar) do { unsigned _sp = 0; while (cond) { __builtin_amdgcn_s_sleep(1); \
    if ((++_sp & 255u) == 0u) { if (xb_ld(&(bar)[XB_TMO])) break; if (_sp > XB_SPIN_CAP) { atomicAdd(&(bar)[XB_TMO], 1u); break; } } } } while (0)
struct XcdBarrier { unsigned* bar; unsigned x; volatile LASQ unsigned* st; };
__device__ __forceinline__ XcdBarrier xcd_barrier_post(unsigned* bar, volatile LASQ unsigned* st) {
    XcdBarrier b; b.bar = bar; b.x = xb_xcc_id(); b.st = st;
    if (threadIdx.x == 0) (void)xb_add(&bar[XB_XCNT(b.x)], 1u);
    return b;
}
__device__ __forceinline__ void xcd_barrier_complete(unsigned* bar, unsigned x, unsigned& nloc, unsigned& nx) {
    const unsigned G = gridDim.x * gridDim.y * gridDim.z;
    unsigned sum, cnt, mine, sp = 0u;
    for (;;) {
        sum = 0u; cnt = 0u; mine = 0u;
#pragma unroll
        for (unsigned j = 0; j < 16; ++j) { const unsigned c = xb_ld(&bar[XB_XCNT(j)]); sum += c; cnt += (c > 0u) ? 1u : 0u; mine = (j == x) ? c : mine; }
        if (sum == G) break;
        __builtin_amdgcn_s_sleep(1);
        if ((++sp & 255u) == 0u) { if (xb_ld(&bar[XB_TMO])) break; if (sp > XB_SPIN_CAP) { atomicAdd(&bar[XB_TMO], 1u); break; } }
    }
    nloc = mine > 0u ? mine : 1u; nx = cnt > 0u ? cnt : 1u;
}
__device__ __forceinline__ void xcd_barrier(const XcdBarrier& b) {
    asm volatile("s_waitcnt vmcnt(0)" ::: "memory");
    __syncthreads();
    if (threadIdx.x == 0) {
        unsigned* bar = b.bar;
        __builtin_amdgcn_s_waitcnt(0);
        unsigned nloc = b.st[0], nx = b.st[1];
        if (nloc == 0u) { xcd_barrier_complete(bar, b.x, nloc, nx); b.st[0] = nloc; b.st[1] = nx; }
        const unsigned old = xb_add(&bar[XB_XSUB(b.x)], 1u);
        const unsigned gen = old / nloc;
        if (old + 1u == (gen + 1u) * nloc) {
            __builtin_amdgcn_fence(__ATOMIC_RELEASE, "agent");
            asm volatile("s_waitcnt vmcnt(0)" ::: "memory");
            const unsigned og = xb_add(&bar[XB_TOP], 1u);
            const unsigned tg = og / nx;
            if (og + 1u == (tg + 1u) * nx) xb_add(&bar[XB_TOPGEN], 1u);
            else XB_SPIN(xb_ld(&bar[XB_TOPGEN]) == tg, bar);
            __builtin_amdgcn_fence(__ATOMIC_ACQUIRE, "agent");
            xb_add(&bar[XB_XGEN(b.x)], 1u);
            asm volatile("s_waitcnt vmcnt(0)" ::: "memory");
        } else {
            XB_SPIN(xb_ld(&bar[XB_XGEN(b.x)]) == gen, bar);
            __builtin_amdgcn_fence(__ATOMIC_ACQUIRE, "agent");
            asm volatile("s_waitcnt vmcnt(0)" ::: "memory");
        }
    }
    __syncthreads();
}
constexpr int PROBE_ID = 0, PROBE_MULT = 4;
#define PB(id) do { if (PROBE_ID == (id) && blockIdx.x == 0) { tp0 = __builtin_amdgcn_s_memrealtime(); } } while (0)
#define PE(id) do { if (PROBE_ID == (id) && blockIdx.x == 0) { tacc += __builtin_amdgcn_s_memrealtime() - tp0; } } while (0)
#define GSYNC() do { PB(13); xcd_barrier(xbar); PE(13); } while (0)
__global__ void __launch_bounds__(512, 2) mega(Params p) {
    unsigned long long tp0 = 0, tacc = 0;
    extern __shared__ __attribute__((aligned(16))) unsigned char lds[];
    cg::grid_group grid = cg::this_grid();
    PG8_LAS unsigned char* L = (PG8_LAS unsigned char*)lds;
    const int G = gridDim.x, bx = blockIdx.x; const int tidx = pg8_tid_fresh();
    float* mod = (float*)(p.ws + WS_MOD);
    bf16_t* hA = (bf16_t*)(p.ws + WS_R);
    if (threadIdx.x < 4) ((volatile LASQ unsigned*)(L + 131072))[threadIdx.x] = 0u;
    __syncthreads();
    XcdBarrier xbar = xcd_barrier_post((unsigned*)(p.ws + WS_BAR), (volatile LASQ unsigned*)(L + 131072));
    if (p.ws == nullptr) grid.sync();
    PB(1);
    { float* ssq = (float*)(p.ws + WS_SSQ); for (int i = bx * NT + tidx; i < 131072; i += G * NT) ssq[i] = 0.f;
      { float* z2 = (float*)(p.ws + WS_SMALL2); for (int i = bx * NT + tidx; i < (int)((WS_SMALL2_END - WS_SMALL2) / 4); i += G * NT) z2[i] = 0.f; }
      phase_ada(p, lds);
      int g = bx, base = 0; TrJob j0{p.in[8], (bf16_t*)(p.ws + WS_WIN), 1024, 6208}, j1{p.in[15], (bf16_t*)(p.ws + WS_WOUT), 2048, 1024};
      tr_job(j0, g, base, (float*)lds); tr_job(j1, g, base, (float*)lds); }
    GSYNC();
    norm_rows(p.in[0], 16384, -1, p.in[6], mod, 0, 1024, hA);
    norm_rows(p.in[2], 2048, 8, p.in[6], mod, 0, 1024, hA + (size_t)16384 * 1024);
    GSYNC();
    PE(1); PB(2);
    { pg8::Gemm g{hA, (const bf16_t*)(p.ws + WS_WIN), 18432, 6400, 1024}; InProjOrder S; S.init(G, bx);
      EpiInProj E{(bf16_t*)p.out, (bf16_t*)(p.ws + WS_XBC), (float*)(p.ws + WS_DT), p.in[11], p.in[9], p.in[10], L + 131088};
      pg8::gemm_phase<EpiInProj, InProjOrder, true, true>(L, g, S, E); }
    if (G == 256 && bx >= 200) {
        int g2 = bx - 200, base2 = 0; TrJob ja{p.in[20], (bf16_t*)(p.ws + WS_W2T0), 3136, 1024, 4096};
        tr_job(ja, g2, base2, (float*)lds, nullptr, nullptr, 56); }
    GSYNC();
    PE(2); PB(4);
    phase_ssd(p, L);
    GSYNC();
    PE(4); PB(5);
    phase_gnorm(p);
    { int g = bx, base = 0; const float* mod1 = mod + 9 * 6144;
      TrJob j0{p.in[19], (bf16_t*)(p.ws + WS_W1T0), 1024, 4096}, j1{G == 256 ? p.in[20] + (size_t)3136 * 1024 : p.in[20], (bf16_t*)(p.ws + WS_W2T0) + (G == 256 ? 3136 : 0), G == 256 ? 960 : 4096, 1024, 4096},
            j2{p.in[16], (bf16_t*)(p.ws + WS_SCIN2), 1024, 3072}, j3{p.in[18], (bf16_t*)(p.ws + WS_SCOUT2), 1024, 1024};
      tr_job(j0, g, base, (float*)lds, mod + 3072, (float*)(p.ws + WS_BW1)); tr_job(j1, g, base, (float*)lds);
      tr_job(j2, g, base, (float*)lds, mod1, (float*)(p.ws + WS_BSC)); tr_job(j3, g, base, (float*)lds); }
    GSYNC();
    PE(5);
#pragma unroll 1
    for (int l = 0; l < 2; ++l) {
        const float* modl = mod + l * 9 * 6144;
        float* rowss = (float*)(p.ws + WS_ROWSS);
        bf16_t* const res0 = (bf16_t*)p.out; bf16_t* const a2buf = (bf16_t*)p.out + (size_t)16384 * 1024; bf16_t* const res1 = (bf16_t*)(p.ws + WS_A2);
        bf16_t* Amlp = l == 0 ? (bf16_t*)(p.ws + WS_A1) : a2buf;
        if (l == 0) PB(6);
        { pg8::Gemm g{l == 0 ? (const bf16_t*)(p.ws + WS_R) : (const bf16_t*)(p.ws + WS_SCV), l == 0 ? (const bf16_t*)(p.ws + WS_WOUT) : (const bf16_t*)(p.ws + WS_SCOUT2), 16384, 1024, l == 0 ? 2048 : 1024};
          pg8::StaticOrder S; S.init(16384, 1024, G, bx);
          EpiRes E{l == 0 ? p.in[0] : (const float*)nullptr, res1, l == 0 ? res0 : res1, modl + 2048, Amlp, p.in[7] + l * 1024, modl + 4096, rowss + (l == 0 ? 0 : 2 * 16384)};
          pg8::gemm_phase<EpiRes, pg8::StaticOrder, true, true>(L, g, S, E); }
        GSYNC();
        if (l == 0) { PE(6); }
        PB(8);
        { pg8::Gemm g{Amlp, l == 0 ? (const bf16_t*)(p.ws + WS_W1T0) : (const bf16_t*)(p.ws + WS_W1T1), 16384, 4096, 1024}; pg8::StaticOrder S; S.init(16384, 4096, G, bx);
          EpiAct E{(bf16_t*)(p.ws + WS_U2), 4096, 1, rowss + (l == 0 ? 0 : 2 * 16384), (const float*)(p.ws + WS_BW1) + (size_t)l * 8 * 4096};
          pg8::gemm_phase<EpiAct, pg8::StaticOrder, true, true>(L, g, S, E); }
        GSYNC();
        PE(8); PB(9);
        if (l == 0) {
            pg8::Gemm g{(const bf16_t*)(p.ws + WS_U2), (const bf16_t*)(p.ws + WS_W2T0), 16384, 1024, 4096}; pg8::StaticOrder S; S.init(16384, 1024, G, bx);
            EpiRes E{(const float*)nullptr, res0, res1, modl + 5120, a2buf, p.in[6] + 1024, mod + 9 * 6144 + 1024, rowss + 16384};
            pg8::gemm_phase<EpiRes, pg8::StaticOrder, true, true>(L, g, S, E);
        } else {
            pg8::Gemm g{(const bf16_t*)(p.ws + WS_U2), (const bf16_t*)(p.ws + WS_W2T1), 16384, 1024, 4096}; pg8::StaticOrder S; S.init(16384, 1024, G, bx);
            EpiResFin E{res1, p.out, modl + 5120, rowss + 3 * 16384, p.in[21], (unsigned*)(p.ws + WS_PCNT)};
            pg8::gemm_phase<EpiResFin, pg8::StaticOrder, false, true>(L, g, S, E);
        }
        if (l == 0) GSYNC();
        PE(9);
        if (l == 0) {
            PB(11);
            { pg8::Gemm g{a2buf, (const bf16_t*)(p.ws + WS_SCIN2), 16384, 3072, 1024}; pg8::StaticOrder S; S.init(16384, 3072, G, bx);
              EpiAct E{(bf16_t*)(p.ws + WS_SCP), 3072, 0, rowss + 16384, (const float*)(p.ws + WS_BSC)}; pg8::gemm_phase<EpiAct, pg8::StaticOrder, true, true>(L, g, S, E); }
            GSYNC();
            PE(11); PB(12);
            phase_scconv(p);
            { int g = bx, base = 0; const float* mod1 = mod + 9 * 6144;
              TrJob j0{p.in[19] + (size_t)1024 * 4096, (bf16_t*)(p.ws + WS_W1T1), 1024, 4096}, j1{p.in[20] + (size_t)4096 * 1024, (bf16_t*)(p.ws + WS_W2T1), 4096, 1024};
              tr_job(j0, g, base, (float*)lds, mod1 + 3072, (float*)(p.ws + WS_BW1) + (size_t)8 * 4096); tr_job(j1, g, base, (float*)lds); }
            GSYNC();
            PE(12);
        }
    }
    if (PROBE_ID != 0 && blockIdx.x == 0) { const unsigned long long ts = __builtin_amdgcn_s_memrealtime(); while (__builtin_amdgcn_s_memrealtime() - ts < (unsigned long long)PROBE_MULT * tacc) __builtin_amdgcn_s_sleep(20); }
}

extern "C" void kernel_launch(void* const* d_in, const int* in_sizes, int n_in, void* d_out, int out_size, void* d_ws, size_t ws_size, hipStream_t stream) {
    static int grid_blocks = 0;
    if (!grid_blocks) {
        int dev = 0, cus = 0, per_cu = 0;
        hipGetDevice(&dev);
        hipDeviceGetAttribute(&cus, hipDeviceAttributeMultiprocessorCount, dev);
        if (hipFuncSetAttribute((const void*)mega, hipFuncAttributeMaxDynamicSharedMemorySize, LDS_BYTES) != hipSuccess) fprintf(stderr, "kernel_launch: hipFuncSetAttribute failed\n");
        hipOccupancyMaxActiveBlocksPerMultiprocessor(&per_cu, (const void*)mega, NT, LDS_BYTES);
        if (per_cu < 1) { fprintf(stderr, "kernel_launch: occupancy query says %d blocks per CU\n", per_cu); per_cu = 1; }
        grid_blocks = cus;
        if (n_in != 22 || ws_size < WS_END_A) fprintf(stderr, "kernel_launch: unexpected n_in %d / ws_size %zu\n", n_in, ws_size);
    }
    Params p{};
    for (int i = 0; i < 22; ++i) p.in[i] = (const float*)d_in[i];
    p.out = (float*)d_out; p.ws = (unsigned char*)d_ws;
    (void)hipMemsetAsync((unsigned char*)d_ws + WS_BAR, 0, XCD_BAR_WORDS * 4, stream);
    void* args[] = {&p};
    hipError_t e = hipLaunchCooperativeKernel((const void*)mega, dim3(grid_blocks), dim3(NT), args, LDS_BYTES, stream);
    if (e != hipSuccess) fprintf(stderr, "cooperative launch failed: %s (grid %d)\n", hipGetErrorString(e), grid_blocks);
}
```

```cpp
#include <hip/hip_runtime.h>
#include <hip/hip_cooperative_groups.h>
#include <cstdio>
namespace cg = cooperative_groups;
__device__ __forceinline__ int pg8_tid_fresh() { int t = threadIdx.x; asm volatile("" : "+v"(t)); return t; }
namespace pg8 {
#define PG8_LAS __attribute__((address_space(3)))
typedef unsigned short bf16_t;
typedef short bf16x8 __attribute__((ext_vector_type(8)));
typedef float f32x4 __attribute__((ext_vector_type(4)));
typedef unsigned u32x4 __attribute__((ext_vector_type(4)));
constexpr int BM = 256, BK = 64, HALF = 128, HTB = HALF * BK * 2  , STAGE_BYTES = 8 * HTB, NXCD = 8, WGM = 8;

__host__ __device__ __forceinline__ int lds_byte(int r, int c) { const int st = (r >> 4) * 2 + (c >> 5), rr = r & 15, cc = c & 31, ob = rr * 64 + cc * 2; return st * 1024 + (ob ^ (((ob >> 9) & 1) << 5)); }
__host__ __device__ __forceinline__ void stage_rc(int b, int& R, int& C) { const int st = b / 1024, sb = b % 1024, swz = sb ^ (((sb >> 9) & 1) << 5); R = (st >> 1) * 16 + swz / 64; C = (st & 1) * 32 + (swz % 64) / 2; }
__host__ __device__ __forceinline__ int perm32(int rho) { const int n = rho >> 4, i = rho & 15; return 8 * (i >> 2) + 4 * n + (i & 3); }

struct Unit { int pm, pn; };
struct Gemm { const bf16_t* A; const bf16_t* Bt; int M, N, K; };

struct StaticOrder {
    int nM, nN, nwg, G, c;
    __host__ __device__ void init(int M, int N, int G_, int c_) { nM = M / BM; nN = N / BM; nwg = nM * nN; G = G_; c = c_; }
    __host__ __device__ bool next(int i, Unit& u) const {
        const long L = (long)i * G + c; if (L >= nwg) return false;
        int wgid = (int)L; { const int q = nwg / NXCD, r = nwg % NXCD, xcd = wgid % NXCD, off = wgid / NXCD; wgid = (xcd < r ? xcd * (q + 1) : r * (q + 1) + (xcd - r) * q) + off; }
        const int nig = WGM * nN, gid = wgid / nig, fm = gid * WGM, gsz = (nM - fm) < WGM ? (nM - fm) : WGM;
        u.pm = fm + ((wgid % nig) % gsz); u.pn = (wgid % nig) / gsz; return true;
    }
    __device__ __forceinline__ void a_ready(const Unit&) const {}
    __device__ __forceinline__ void done(const Unit&) const {}
};
__device__ __forceinline__ unsigned cvt_pk_bf16(float lo, float hi) { unsigned r; asm volatile("v_cvt_pk_bf16_f32 %0, %1, %2" : "=v"(r) : "v"(lo), "v"(hi)); return r; }
template <class Epi, class Sched, bool ALIGN_EPI = false, bool SP2 = false>
__device__ __forceinline__ void gemm_phase(PG8_LAS unsigned char* lds, const Gemm g, const Sched& S, const Epi& E) {
    const int tid = pg8_tid_fresh(), wid = __builtin_amdgcn_readfirstlane(tid >> 6), lane = tid & 63, wr = wid >> 2, wc = wid & 3, fr = lane & 15, fq = lane >> 4;
    const int K = g.K, nt = K / BK;
    unsigned voffA[2], voffB[2];
#pragma unroll
    for (int i = 0; i < 2; ++i) { int R, C; stage_rc(tid * 16 + i * 8192, R, C); const int Rb = Epi::PERM ? ((R & ~31) + perm32(R & 31)) : R;
        voffA[i] = (unsigned)(R * K + C) * 2u; voffB[i] = (unsigned)(Rb * K + C) * 2u; }
    const size_t kstep = (size_t)(BK * 2);
    const size_t hstep = (size_t)HALF * K * 2;
    const size_t tstep = 2 * hstep;
    const unsigned ldsw = (unsigned)wid * 1024u;
    const int aoff = lds_byte(wr * 64 + fr, fq * 8), boff = lds_byte(wc * 32 + fr, fq * 8);
#define PG8_SA(b, h) (((b) * 2 + (h)) * HTB)
#define PG8_SB(b, h) ((4 + (b) * 2 + (h)) * HTB)
#define PG8_STAGE(bufoff, gbase, voff) do { _Pragma("unroll") for (int _i = 0; _i < 2; ++_i) \
        __builtin_amdgcn_global_load_lds((const unsigned*)((const char*)(gbase) + (voff)[_i]), (PG8_LAS unsigned*)(lds + (bufoff) + ldsw + _i * 8192), 16, 0, 0); } while (0)
#define PG8_LDA(dst, b, h) do { _Pragma("unroll") for (int m = 0; m < 4; ++m) _Pragma("unroll") for (int k = 0; k < 2; ++k) dst[m][k] = *(const PG8_LAS bf16x8*)(lds + PG8_SA(b, h) + aoff + m * 2048 + k * 1024); } while (0)
#define PG8_LDB(dst, b, h) do { _Pragma("unroll") for (int n = 0; n < 2; ++n) _Pragma("unroll") for (int k = 0; k < 2; ++k) dst[n][k] = *(const PG8_LAS bf16x8*)(lds + PG8_SB(b, h) + boff + n * 2048 + k * 1024); } while (0)
#define PG8_MMA(ai, bj, At, Bt) do { __builtin_amdgcn_s_setprio(1); _Pragma("unroll") for (int m = 0; m < 4; ++m) _Pragma("unroll") for (int n = 0; n < 2; ++n) _Pragma("unroll") for (int k = 0; k < 2; ++k) \
        acc[ai][bj][m][n] = __builtin_amdgcn_mfma_f32_16x16x32_bf16(Bt[n][k], At[m][k], acc[ai][bj][m][n], 0, 0, 0); __builtin_amdgcn_s_setprio(0); } while (0)
#define PG8_WAIT_V(n) asm volatile("s_waitcnt vmcnt(" #n ")" ::: "memory")
#define PG8_WAIT_L(n) asm volatile("s_waitcnt lgkmcnt(" #n ")" ::: "memory")
#define PG8_BAR __builtin_amdgcn_s_barrier()
#define PG8_SCHED __builtin_amdgcn_sched_barrier(0)
    Unit cur, nxt; int ui = 0;
    if (!S.next(0, cur)) return;
    f32x4 acc[2][2][4][2];
#pragma unroll
    for (int a = 0; a < 2; ++a)
#pragma unroll
        for (int b = 0; b < 2; ++b)
#pragma unroll
            for (int m = 0; m < 4; ++m)
#pragma unroll
                for (int n = 0; n < 2; ++n) acc[a][b][m][n] = (f32x4){0.f, 0.f, 0.f, 0.f};
    bf16x8 At[4][2], B0[2][2], B1[2][2];
    const char* cA = (const char*)g.A + (size_t)cur.pm * tstep; const char* cB = (const char*)g.Bt + (size_t)cur.pn * tstep;
    S.a_ready(cur);
    if constexpr (SP2) {
        PG8_STAGE(PG8_SB(0, 0), cB, voffB); PG8_STAGE(PG8_SB(0, 1), cB + hstep, voffB); PG8_STAGE(PG8_SA(0, 0), cA, voffA); PG8_STAGE(PG8_SA(0, 1), cA + hstep, voffA);
        if (wr == 1) PG8_BAR;
        PG8_WAIT_V(2); PG8_BAR;
        PG8_STAGE(PG8_SB(1, 0), cB + kstep, voffB); PG8_STAGE(PG8_SA(1, 0), cA + kstep, voffA); PG8_STAGE(PG8_SB(1, 1), cB + hstep + kstep, voffB);
        PG8_WAIT_V(6); PG8_BAR;
    } else {
        PG8_STAGE(PG8_SB(0, 0), cB, voffB); PG8_STAGE(PG8_SA(0, 0), cA, voffA); PG8_STAGE(PG8_SB(0, 1), cB + hstep, voffB); PG8_STAGE(PG8_SA(0, 1), cA + hstep, voffA);
        if (wr == 1) PG8_BAR;
        PG8_WAIT_V(4); PG8_BAR;
        PG8_STAGE(PG8_SB(1, 0), cB + kstep, voffB); PG8_STAGE(PG8_SA(1, 0), cA + kstep, voffA); PG8_STAGE(PG8_SB(1, 1), cB + hstep + kstep, voffB);
        PG8_WAIT_V(6); PG8_BAR;
    }
    for (;;) {
        const bool has_next = S.next(ui + 1, nxt);
        const char* nA = has_next ? (const char*)g.A + (size_t)nxt.pm * tstep : cA; const char* nB = has_next ? (const char*)g.Bt + (size_t)nxt.pn * tstep : cB;
        for (int t = 0; t < nt; t += 2) {
            const bool last = (t == nt - 2);
            const char* a1 = cA + (size_t)(t + 1) * kstep;
            const char* a2 = last ? nA : cA + (size_t)(t + 2) * kstep; const char* b2 = last ? nB : cB + (size_t)(t + 2) * kstep;
            const char* a3 = a2 + kstep; const char* b3 = b2 + kstep;
            if (last && has_next) S.a_ready(nxt);
            if constexpr (SP2) {
            PG8_LDB(B0, 0, 0); PG8_LDB(B1, 0, 1); PG8_SCHED; PG8_LDA(At, 0, 0); PG8_STAGE(PG8_SA(1, 1), a1 + hstep, voffA);
            PG8_WAIT_V(8); PG8_WAIT_L(0); PG8_BAR; PG8_MMA(0, 0, At, B0); PG8_MMA(0, 1, At, B1); PG8_BAR; PG8_SCHED;
            PG8_LDA(At, 0, 1); PG8_STAGE(PG8_SB(0, 0), b2, voffB); PG8_STAGE(PG8_SB(0, 1), b2 + hstep, voffB); PG8_STAGE(PG8_SA(0, 0), a2, voffA);
            PG8_WAIT_V(8); PG8_WAIT_L(0); PG8_BAR; PG8_MMA(1, 0, At, B0); PG8_MMA(1, 1, At, B1); PG8_BAR; PG8_SCHED;
            PG8_LDB(B0, 1, 0); PG8_LDB(B1, 1, 1); PG8_SCHED; PG8_LDA(At, 1, 0); PG8_STAGE(PG8_SA(0, 1), a2 + hstep, voffA);
            PG8_WAIT_V(8); PG8_WAIT_L(0); PG8_BAR; PG8_MMA(0, 0, At, B0); PG8_MMA(0, 1, At, B1); PG8_BAR; PG8_SCHED;
            PG8_LDA(At, 1, 1); PG8_STAGE(PG8_SB(1, 0), b3, voffB); PG8_STAGE(PG8_SB(1, 1), b3 + hstep, voffB); PG8_STAGE(PG8_SA(1, 0), a3, voffA);
            PG8_WAIT_V(8); PG8_WAIT_L(0); PG8_BAR; PG8_MMA(1, 0, At, B0); PG8_MMA(1, 1, At, B1); PG8_BAR; PG8_SCHED;
            } else {
            PG8_LDB(B0, 0, 0); PG8_SCHED; PG8_LDA(At, 0, 0); PG8_STAGE(PG8_SA(1, 1), a1 + hstep, voffA);
            PG8_WAIT_L(8); PG8_BAR; PG8_WAIT_L(0); PG8_MMA(0, 0, At, B0); PG8_BAR; PG8_SCHED;
            PG8_LDB(B1, 0, 1); PG8_STAGE(PG8_SB(0, 0), b2, voffB);
            PG8_BAR; PG8_WAIT_L(0); PG8_MMA(0, 1, At, B1); PG8_BAR;
            PG8_LDA(At, 0, 1); PG8_STAGE(PG8_SA(0, 0), a2, voffA);
            PG8_BAR; PG8_WAIT_L(0); PG8_MMA(1, 0, At, B0); PG8_BAR; PG8_SCHED;
            PG8_STAGE(PG8_SB(0, 1), b2 + hstep, voffB);
            PG8_WAIT_V(6); PG8_BAR; PG8_MMA(1, 1, At, B1); PG8_BAR;
            PG8_LDB(B0, 1, 0); PG8_SCHED; PG8_LDA(At, 1, 0); PG8_STAGE(PG8_SA(0, 1), a2 + hstep, voffA);
            PG8_WAIT_L(8); PG8_BAR; PG8_WAIT_L(0); PG8_MMA(0, 0, At, B0); PG8_BAR; PG8_SCHED;
            PG8_LDB(B1, 1, 1); PG8_STAGE(PG8_SB(1, 0), b3, voffB);
            PG8_BAR; PG8_WAIT_L(0); PG8_MMA(0, 1, At, B1); PG8_BAR;
            PG8_LDA(At, 1, 1); PG8_STAGE(PG8_SA(1, 0), a3, voffA);
            PG8_BAR; PG8_WAIT_L(0); PG8_MMA(1, 0, At, B0); PG8_BAR; PG8_SCHED;
            PG8_STAGE(PG8_SB(1, 1), b3 + hstep, voffB);
            PG8_WAIT_V(6); PG8_BAR; PG8_MMA(1, 1, At, B1); PG8_BAR;
            }
        }
        if constexpr (ALIGN_EPI) { if (wr == 0) PG8_BAR; }
        if constexpr (!Epi::AFTER_DRAIN) { E(acc, cur, wr, wc, fr, fq); S.done(cur); }
        if (!has_next) break;
#pragma unroll
        for (int a = 0; a < 2; ++a)
#pragma unroll
            for (int b = 0; b < 2; ++b)
#pragma unroll
                for (int m = 0; m < 4; ++m)
#pragma unroll
                    for (int n = 0; n < 2; ++n) acc[a][b][m][n] = (f32x4){0.f, 0.f, 0.f, 0.f};
        cur = nxt; cA = nA; cB = nB; ++ui;
        if constexpr (ALIGN_EPI) { if (wr == 1) PG8_BAR; }
    }
    PG8_WAIT_V(0);
    if constexpr (!ALIGN_EPI) { if (wr == 0) PG8_BAR; }
    PG8_BAR;
    if constexpr (Epi::AFTER_DRAIN) { E.fused(acc, cur, wr, wc, fr, fq, lds, wid, lane); S.done(cur); }
#undef PG8_SA
#undef PG8_SB
#undef PG8_STAGE
#undef PG8_LDA
#undef PG8_LDB
#undef PG8_MMA
#undef PG8_WAIT_V
#undef PG8_WAIT_L
#undef PG8_BAR
#undef PG8_SCHED
}
}
using pg8::bf16_t; using pg8::bf16x8; using pg8::f32x4; using pg8::u32x4; using pg8::Unit; using pg8::cvt_pk_bf16;
typedef __attribute__((address_space(3))) unsigned char* ldsp;
typedef unsigned u32x2 __attribute__((ext_vector_type(2)));
typedef short s16x4 __attribute__((ext_vector_type(4)));
typedef short v4i16_t __attribute__((ext_vector_type(4)));
#define LASQ __attribute__((address_space(3)))
#define LBAR0() asm volatile("s_waitcnt lgkmcnt(0)\n\ts_barrier" ::: "memory")

constexpr int NT = 512, LDS_BYTES = 131072 + 16 + 8192;
constexpr size_t WS_BAR = 458752;
constexpr size_t WS_MOD = 0, WS_SSQ = 524288, WS_WIN = 1048576, WS_WOUT = WS_WIN + 13107200, WS_XBC = WS_WOUT + 4194304, WS_DT = WS_XBC + 150994944,
                 WS_R = WS_DT + 4718592, WS_XBCC = WS_R + 67108864, WS_END_A = WS_XBCC + 16777216;
constexpr size_t WS_U = WS_XBC, WS_SCP = WS_XBC, WS_SCV = WS_XBC + 100663296, WS_W1T = WS_R + 33554432, WS_W2T = WS_W1T + 16777216,
                 WS_SCIN = WS_W2T + 16777216, WS_SCOUT = WS_SCIN + 6291456, WS_END_B = WS_SCOUT + 2097152;
constexpr size_t WS_SMALL2 = WS_END_A, WS_ROWSS = WS_SMALL2, WS_BW1 = WS_ROWSS + 262144, WS_BSC = WS_BW1 + 262144, WS_PCNT = WS_BSC + 98304, WS_SMALL2_END = WS_PCNT + 16384;
constexpr size_t WS_W2T0 = WS_SMALL2 + 1048576, WS_W1T0 = WS_WIN, WS_SCIN2 = WS_XBCC, WS_SCOUT2 = WS_XBCC + 6291456;
constexpr size_t WS_A1 = WS_XBC, WS_U2 = WS_XBC + 33554432, WS_A2 = WS_R + 16777216, WS_W1T1 = WS_R + 50331648, WS_W2T1 = WS_W1T1 + 8388608;
static_assert(WS_END_A <= 268435456 && WS_SMALL2_END <= WS_W2T0 && WS_W2T0 + 8388608 <= 268435456 && WS_U2 + 134217728 <= WS_A2 && WS_W2T1 + 8388608 <= WS_XBCC && WS_SCV + 33554432 <= WS_DT, "workspace map");

struct Params { const float* in[22]; float* out; unsigned char* ws; };

__device__ __forceinline__ float wave_sum(float v) {
#pragma unroll
    for (int o = 32; o >= 1; o >>= 1) v += __shfl_xor(v, o);
    return v; }
__device__ __forceinline__ float silu_f(float v) { return v * __builtin_amdgcn_rcpf(1.0f + __expf(-v)); }
__device__ __forceinline__ float softplus_f(float x) { return x > 20.f ? x : log1pf(__expf(x)); }
__device__ __forceinline__ float bf_lo(unsigned u) { return __uint_as_float(u << 16); }
__device__ __forceinline__ float bf_hi(unsigned u) { return __uint_as_float(u & 0xffff0000u); }

__device__ __forceinline__ void phase_ada(const Params& p, unsigned char* lds) {
    const int tidx = pg8_tid_fresh();
    float* s_c = (float*)lds;
    float* part = (float*)(lds + 36864);
    float* mod = (float*)(p.ws + WS_MOD);
    const int tid = tidx;
    for (int i = tid; i < 9 * 1024; i += NT) { const int b = i >> 10, k = i & 1023; const float v = b < 8 ? p.in[1][b * 1024 + k] : p.in[3][k]; s_c[i] = silu_f(v); }
    __syncthreads();
    for (int item = blockIdx.x; item < 256; item += gridDim.x) {
        const int l = item >> 7, col0 = (item & 127) * 48;
        const float* W = p.in[4] + (size_t)l * 1024 * 6144;
        if (tid < 384) {
            const int c4 = tid % 12, ks = tid / 12;
            float acc[9][4];
#pragma unroll
            for (int b = 0; b < 9; ++b)
#pragma unroll
                for (int j = 0; j < 4; ++j) acc[b][j] = 0.f;
#pragma unroll 4
            for (int kk = 0; kk < 32; ++kk) {
                const int k = ks + 32 * kk; const f32x4 w = *(const f32x4*)(W + (size_t)k * 6144 + col0 + c4 * 4);
#pragma unroll
                for (int b = 0; b < 9; ++b) { const float s = s_c[b * 1024 + k];
#pragma unroll
                    for (int j = 0; j < 4; ++j) acc[b][j] += s * w[j]; }
            }
#pragma unroll
            for (int b = 0; b < 9; ++b)
#pragma unroll
                for (int j = 0; j < 4; ++j) part[(ks * 9 + b) * 48 + c4 * 4 + j] = acc[b][j];
        }
        __syncthreads();
        if (tid < 432) { const int b = tid / 48, j = tid % 48; float s = p.in[5][l * 6144 + col0 + j];
            for (int ks = 0; ks < 32; ++ks) s += part[(ks * 9 + b) * 48 + j];
            mod[(l * 9 + b) * 6144 + col0 + j] = s; }
        __syncthreads();
    }
}
struct TrJob { const float* W; bf16_t* Wt; int K, N; };
__device__ __forceinline__ void tr_job(const TrJob& j, int& g, int& base, float* tl, const float* shv = nullptr, float* biasout = nullptr) {
    const int tidx = pg8_tid_fresh();
    const int ntn = j.N / 64, nt = (j.K / 64) * ntn, N = j.N, K = j.K;
    const int r0 = tidx >> 4, c4 = tidx & 15, n = tidx >> 3, k8 = tidx & 7;
    f32x4 cur[2];
    if (g < base + nt) { const int local = g - base, tk = local / ntn, tn = local % ntn;
#pragma unroll
        for (int i = 0; i < 2; ++i) cur[i] = *(const f32x4*)(j.W + (size_t)(tk * 64 + r0 + 32 * i) * N + tn * 64 + c4 * 4); }
    while (g < base + nt) {
        const int local = g - base, tk = local / ntn, tn = local % ntn, gn = g + gridDim.x;
        f32x4 nxt[2] = {cur[0], cur[1]};
        if (gn < base + nt) { const int l2 = gn - base, tk2 = l2 / ntn, tn2 = l2 % ntn;
#pragma unroll
            for (int i = 0; i < 2; ++i) nxt[i] = *(const f32x4*)(j.W + (size_t)(tk2 * 64 + r0 + 32 * i) * N + tn2 * 64 + c4 * 4); }
#pragma unroll
        for (int i = 0; i < 2; ++i) { float* d = tl + (r0 + 32 * i) * 65 + c4 * 4; d[0] = cur[i][0]; d[1] = cur[i][1]; d[2] = cur[i][2]; d[3] = cur[i][3]; }
        LBAR0();
        { float f[8];
#pragma unroll
          for (int q = 0; q < 8; ++q) f[q] = tl[(k8 * 8 + q) * 65 + n];
          u32x4 w; w.x = cvt_pk_bf16(f[0], f[1]); w.y = cvt_pk_bf16(f[2], f[3]); w.z = cvt_pk_bf16(f[4], f[5]); w.w = cvt_pk_bf16(f[6], f[7]);
          *(u32x4*)(j.Wt + (size_t)(tn * 64 + n) * K + tk * 64 + k8 * 8) = w; }
        if (biasout) { const int bb = __builtin_amdgcn_readfirstlane(tidx >> 6), nn = tidx & 63; const float* sp = shv + bb * 6144 + tk * 64; float s = 0.f;
#pragma unroll 8
            for (int k = 0; k < 64; ++k) s += sp[k] * tl[k * 65 + nn];
            atomicAdd(biasout + (size_t)bb * N + tn * 64 + nn, s); }
        LBAR0();
        cur[0] = nxt[0]; cur[1] = nxt[1]; g = gn;
    }
    base += nt;
}

__device__ __forceinline__ void norm_rows(const float* src, int nrows, int bfix, const float* g, const float* modl, int osh, int osc, bf16_t* dst) {
    const int tidx = pg8_tid_fresh();
    const int lane = tidx & 63, wave = tidx >> 6, stride = gridDim.x * 8;
    for (int r0 = blockIdx.x * 8 + wave; r0 < nrows; r0 += 2 * stride) {
        f32x4 v[2][4]; float ss[2] = {0.f, 0.f};
#pragma unroll
        for (int u = 0; u < 2; ++u) { const int r = r0 + u * stride; if (r < nrows) {
#pragma unroll
            for (int i = 0; i < 4; ++i) v[u][i] = *(const f32x4*)(src + (size_t)r * 1024 + i * 256 + lane * 4); } else {
#pragma unroll
            for (int i = 0; i < 4; ++i) v[u][i] = (f32x4){0.f, 0.f, 0.f, 0.f}; } }
#pragma unroll
        for (int u = 0; u < 2; ++u) {
#pragma unroll
            for (int i = 0; i < 4; ++i) ss[u] += v[u][i][0] * v[u][i][0] + v[u][i][1] * v[u][i][1] + v[u][i][2] * v[u][i][2] + v[u][i][3] * v[u][i][3];
            ss[u] = wave_sum(ss[u]); }
#pragma unroll
        for (int u = 0; u < 2; ++u) { const int r = r0 + u * stride; if (r < nrows) {
            const float rstd = rsqrtf(ss[u] * (1.0f / 1024.0f) + 1e-6f);
            const int b = bfix >= 0 ? bfix : (r >> 11);
            const float* mb = modl + b * 6144;
#pragma unroll
            for (int i = 0; i < 4; ++i) { const int col = i * 256 + lane * 4; const f32x4 gg = *(const f32x4*)(g + col), sh = *(const f32x4*)(mb + osh + col), sc = *(const f32x4*)(mb + osc + col);
                const f32x4 o = (v[u][i] * rstd * gg) * (sc + 1.0f) + sh; u32x2 w; w.x = cvt_pk_bf16(o[0], o[1]); w.y = cvt_pk_bf16(o[2], o[3]);
                *(u32x2*)(dst + (size_t)r * 1024 + col) = w; } } }
    }
}
__device__ __forceinline__ void final_norm(float* x, const float* g) {
    const int tidx = pg8_tid_fresh();
    const int lane = tidx & 63, wave = tidx >> 6, stride = gridDim.x * 8;
    for (int r0 = blockIdx.x * 8 + wave; r0 < 16384; r0 += 2 * stride) {
        f32x4 v[2][4]; float ss[2] = {0.f, 0.f};
#pragma unroll
        for (int u = 0; u < 2; ++u) { const int r = r0 + u * stride; if (r < 16384) {
#pragma unroll
            for (int i = 0; i < 4; ++i) v[u][i] = *(const f32x4*)(x + (size_t)r * 1024 + i * 256 + lane * 4); } else {
#pragma unroll
            for (int i = 0; i < 4; ++i) v[u][i] = (f32x4){0.f, 0.f, 0.f, 0.f}; } }
#pragma unroll
        for (int u = 0; u < 2; ++u) {
#pragma unroll
            for (int i = 0; i < 4; ++i) ss[u] += v[u][i][0] * v[u][i][0] + v[u][i][1] * v[u][i][1] + v[u][i][2] * v[u][i][2] + v[u][i][3] * v[u][i][3];
            ss[u] = wave_sum(ss[u]); }
#pragma unroll
        for (int u = 0; u < 2; ++u) { const int r = r0 + u * stride; if (r < 16384) {
            const float rstd = rsqrtf(ss[u] * (1.0f / 1024.0f) + 1e-6f);
#pragma unroll
            for (int i = 0; i < 4; ++i) { const int col = i * 256 + lane * 4; const f32x4 gg = *(const f32x4*)(g + col); *(f32x4*)(x + (size_t)r * 1024 + col) = v[u][i] * rstd * gg; } } }
    }
}

struct InProjOrder {
    pg8::StaticOrder so; int G, c;
    __device__ __forceinline__ void init(int G_, int c_) { so.init(16384, 6400, G_, c_); G = G_; c = c_; }
    __device__ __forceinline__ bool next(int i, Unit& u) const {
        int L = i * G + c; if (L < 1600) return so.next(i, u);
        L -= 1600; if (L >= 136) return false;
        u.pm = 64 + (L & 7); u.pn = 8 + (L >> 3); return true; }
    __device__ __forceinline__ void a_ready(const Unit&) const {}
    __device__ __forceinline__ void done(const Unit&) const {}
};
struct EpiInProj {
    static constexpr bool PERM = true, AFTER_DRAIN = false;
    bf16_t* z; bf16_t* xbc; float* dt; const float* dtbias; const float* cw; const float* cb; PG8_LAS unsigned char* xch;
    __device__ __forceinline__ void operator()(const f32x4 (&acc)[2][2][4][2], const Unit& u, int wr, int wc, int fr, int fq) const {
        const int row0 = u.pm * 256 + wr * 64 + fr;
        if (u.pn == 24) {
            if (wc < 2) {
                const f32x4 b0 = *(const f32x4*)(dtbias + wc * 32 + 8 * fq), b1 = *(const f32x4*)(dtbias + wc * 32 + 8 * fq + 4);
#pragma unroll
                for (int ai = 0; ai < 2; ++ai)
#pragma unroll
                    for (int m = 0; m < 4; ++m) { float* rp = dt + (size_t)(row0 + ai * 128 + m * 16) * 64 + wc * 32 + 8 * fq; f32x4 d0 = acc[ai][0][m][0] + b0, d1 = acc[ai][0][m][1] + b1;
#pragma unroll
                        for (int j = 0; j < 4; ++j) { d0[j] = softplus_f(d0[j]); d1[j] = softplus_f(d1[j]); }
                        *(f32x4*)rp = d0; *(f32x4*)(rp + 4) = d1; }
            }
            return;
        }
        if (u.pn >= 8) {
            const int colc = (u.pn - 8) * 256 + wc * 32 + 8 * fq;
            const bool ctxt = u.pm >= 64;
            PG8_LAS float* xf = (PG8_LAS float*)xch;
            if (ctxt) {
#pragma unroll
                for (int ai = 0; ai < 2; ++ai)
#pragma unroll
                    for (int bj = 0; bj < 2; ++bj) { const int cl = (2 * ai + wr) * 256 + bj * 128 + wc * 32 + 8 * fq;
                        if (fr == 0) { *(PG8_LAS f32x4*)(xf + cl) = acc[ai][bj][0][0]; *(PG8_LAS f32x4*)(xf + cl + 4) = acc[ai][bj][0][1]; }
                        if (fr == 15) { *(PG8_LAS f32x4*)(xf + 1024 + cl) = acc[ai][bj][3][0]; *(PG8_LAS f32x4*)(xf + 1024 + cl + 4) = acc[ai][bj][3][1]; } }
                asm volatile("s_waitcnt lgkmcnt(0)" ::: "memory"); __builtin_amdgcn_s_barrier(); asm volatile("" ::: "memory");
            }
#pragma unroll
            for (int bj = 0; bj < 2; ++bj) {
#pragma unroll
                for (int ai = 0; ai < 2; ++ai) {
                    u32x2 pk0[4];
#pragma unroll
                    for (int n = 0; n < 2; ++n) {
                        float o[4][4];
                        const int cwn = colc + bj * 128 + 4 * n; const f32x4 w0n = *(const f32x4*)(cw + cwn), w1n = *(const f32x4*)(cw + 4096 + cwn), w2n = *(const f32x4*)(cw + 8192 + cwn), bbn = *(const f32x4*)(cb + cwn);
                        f32x4 pe = (f32x4){0.f, 0.f, 0.f, 0.f}, ne = (f32x4){0.f, 0.f, 0.f, 0.f};
                        if (ctxt) { const int slab = 2 * ai + wr, cl = bj * 128 + wc * 32 + 8 * fq + 4 * n;
                            if (slab > 0) pe = *(const PG8_LAS f32x4*)(xf + 1024 + (slab - 1) * 256 + cl);
                            if (slab < 3) ne = *(const PG8_LAS f32x4*)(xf + (slab + 1) * 256 + cl); }
#pragma unroll
                        for (int j = 0; j < 4; ++j) {
                            float R0, R1, R2, R3, L0, L1, L2, L3;
                            asm("s_nop 1\n\tv_mov_b32_dpp %0, %8 row_ror:1 row_mask:0xf bank_mask:0xf\n\tv_mov_b32_dpp %1, %9 row_ror:1 row_mask:0xf bank_mask:0xf\n\t"
                                "v_mov_b32_dpp %2, %10 row_ror:1 row_mask:0xf bank_mask:0xf\n\tv_mov_b32_dpp %3, %11 row_ror:1 row_mask:0xf bank_mask:0xf\n\t"
                                "v_mov_b32_dpp %4, %8 row_ror:15 row_mask:0xf bank_mask:0xf\n\tv_mov_b32_dpp %5, %9 row_ror:15 row_mask:0xf bank_mask:0xf\n\t"
                                "v_mov_b32_dpp %6, %10 row_ror:15 row_mask:0xf bank_mask:0xf\n\tv_mov_b32_dpp %7, %11 row_ror:15 row_mask:0xf bank_mask:0xf"
                                : "=&v"(R0), "=&v"(R1), "=&v"(R2), "=&v"(R3), "=&v"(L0), "=&v"(L1), "=&v"(L2), "=&v"(L3)
                                : "v"(acc[ai][bj][0][n][j]), "v"(acc[ai][bj][1][n][j]), "v"(acc[ai][bj][2][n][j]), "v"(acc[ai][bj][3][n][j]));
                            const float Rm[5] = {pe[j], R0, R1, R2, R3}, Lm[5] = {L0, L1, L2, L3, ne[j]};
#pragma unroll
                            for (int m = 0; m < 4; ++m) {
                                const float pv = fr == 0 ? Rm[m] : Rm[m + 1], nv = fr == 15 ? Lm[m + 1] : Lm[m];
                                o[m][j] = silu_f(w0n[j] * pv + w1n[j] * acc[ai][bj][m][n][j] + w2n[j] * nv + bbn[j]); } }
#pragma unroll
                        for (int m = 0; m < 4; ++m) { u32x2 q; q.x = cvt_pk_bf16(o[m][0], o[m][1]); q.y = cvt_pk_bf16(o[m][2], o[m][3]);
                            if (n == 0) pk0[m] = q;
                            else { u32x4 w; w.x = pk0[m].x; w.y = pk0[m].y; w.z = q.x; w.w = q.y; *(u32x4*)(xbc + (size_t)(row0 + ai * 128 + m * 16) * 4096 + colc + bj * 128) = w; } }
                    }
                    asm volatile("" ::: "memory"); } }
            if (ctxt) { asm volatile("s_waitcnt lgkmcnt(0)" ::: "memory"); __builtin_amdgcn_s_barrier(); asm volatile("" ::: "memory"); }
            return;
        }
        bf16_t* base; int ldc, colt;
        if (u.pn < 8) { base = z; ldc = 2048; colt = u.pn * 256; } else { base = xbc; ldc = 4096; colt = (u.pn - 8) * 256; }
        const int col0 = colt + wc * 32 + 8 * fq;
#pragma unroll
        for (int ai = 0; ai < 2; ++ai)
#pragma unroll
            for (int m = 0; m < 4; ++m) { bf16_t* rowp = base + (size_t)(row0 + ai * 128 + m * 16) * ldc + col0;
#pragma unroll
                for (int bj = 0; bj < 2; ++bj) { const f32x4 v0 = acc[ai][bj][m][0], v1 = acc[ai][bj][m][1];
                    u32x4 w; w.x = cvt_pk_bf16(v0[0], v0[1]); w.y = cvt_pk_bf16(v0[2], v0[3]); w.z = cvt_pk_bf16(v1[0], v1[1]); w.w = cvt_pk_bf16(v1[2], v1[3]);
                    *(u32x4*)(rowp + bj * 128) = w; } }
    }
};
struct EpiAct {
    static constexpr bool PERM = true, AFTER_DRAIN = false;
    bf16_t* O; int ldc; int act; const float* rowss; const float* bias;
    __device__ __forceinline__ void operator()(const f32x4 (&acc)[2][2][4][2], const Unit& u, int wr, int wc, int fr, int fq) const {
        const int row0 = u.pm * 256 + wr * 64 + fr, col0 = u.pn * 256 + wc * 32 + 8 * fq, b = u.pm >> 3;
        f32x4 bv[2][2];
#pragma unroll
        for (int bj = 0; bj < 2; ++bj)
#pragma unroll
            for (int n = 0; n < 2; ++n) bv[bj][n] = *(const f32x4*)(bias + (size_t)b * ldc + col0 + bj * 128 + 4 * n);
#pragma unroll
        for (int ai = 0; ai < 2; ++ai)
#pragma unroll
            for (int m = 0; m < 4; ++m) { const int row = row0 + ai * 128 + m * 16; bf16_t* rowp = O + (size_t)row * ldc + col0;
                const float rs = rsqrtf(rowss[row] * (1.0f / 1024.0f) + 1e-6f);
#pragma unroll
                for (int bj = 0; bj < 2; ++bj) { f32x4 v0 = acc[ai][bj][m][0] * rs + bv[bj][0], v1 = acc[ai][bj][m][1] * rs + bv[bj][1];
                    if (act) {
#pragma unroll
                        for (int j = 0; j < 4; ++j) { const float a = fmaxf(v0[j], 0.f), c = fmaxf(v1[j], 0.f); v0[j] = a * a; v1[j] = c * c; } }
                    u32x4 w; w.x = cvt_pk_bf16(v0[0], v0[1]); w.y = cvt_pk_bf16(v0[2], v0[3]); w.z = cvt_pk_bf16(v1[0], v1[1]); w.w = cvt_pk_bf16(v1[2], v1[3]);
                    *(u32x4*)(rowp + bj * 128) = w; } }
    }
};
struct ScInOrder {
    pg8::StaticOrder so;
    __device__ __forceinline__ void init(int G_, int c_) { so.init(16384, 1024, G_, c_); }
    __device__ __forceinline__ bool next(int i, Unit& u) const { Unit b; if (i >= 3 || !so.next(0, b)) return false; u.pm = b.pm; u.pn = b.pn + 4 * i; return true; }
    __device__ __forceinline__ void a_ready(const Unit&) const {}
    __device__ __forceinline__ void done(const Unit&) const {}
};
struct EpiScIn {
    static constexpr bool PERM = true, AFTER_DRAIN = false;
    bf16_t* P; bf16_t* V; const float* rowss; const float* bias; const float* cw;
    __device__ __forceinline__ void operator()(const f32x4 (&acc)[2][2][4][2], const Unit& u, int wr, int wc, int fr, int fq) const {
        const int row0 = u.pm * 256 + wr * 64 + fr, col0 = u.pn * 256 + wc * 32 + 8 * fq, b = u.pm >> 3, part = u.pn >> 2;
        if (part < 2) {
#pragma unroll
            for (int ai = 0; ai < 2; ++ai)
#pragma unroll
                for (int m = 0; m < 4; ++m) { const int row = row0 + ai * 128 + m * 16; bf16_t* rowp = P + (size_t)row * 3072 + col0; const float rs = rsqrtf(rowss[row] * (1.0f / 1024.0f) + 1e-6f);
#pragma unroll
                    for (int bj = 0; bj < 2; ++bj) { const float* bp = bias + (size_t)b * 3072 + col0 + bj * 128;
                        const f32x4 v0 = acc[ai][bj][m][0] * rs + *(const f32x4*)bp, v1 = acc[ai][bj][m][1] * rs + *(const f32x4*)(bp + 4);
                        u32x4 w; w.x = cvt_pk_bf16(v0[0], v0[1]); w.y = cvt_pk_bf16(v0[2], v0[3]); w.z = cvt_pk_bf16(v1[0], v1[1]); w.w = cvt_pk_bf16(v1[2], v1[3]);
                        *(u32x4*)(rowp + bj * 128) = w; } }
            return;
        }
        const int chc = col0 - 2048;
#pragma unroll
        for (int bj = 0; bj < 2; ++bj)
#pragma unroll
            for (int ai = 0; ai < 2; ++ai) {
#pragma unroll
                for (int n = 0; n < 2; ++n) {
                    const int c = chc + bj * 128 + 4 * n;
                    int r0l = row0 + ai * 128; asm volatile("" : "+v"(r0l));
                    const f32x4 w0 = *(const f32x4*)(cw + c), w1 = *(const f32x4*)(cw + 1024 + c), w2 = *(const f32x4*)(cw + 2048 + c);
                    const f32x4 bvn = *(const f32x4*)(bias + (size_t)b * 3072 + 2048 + c);
                    float mt[4][4];
#pragma unroll
                    for (int m = 0; m < 4; ++m) { const int row = r0l + m * 16; const u32x2 cg = *(const u32x2*)(P + (size_t)row * 3072 + 1024 + c);
                        const f32x4 xv = acc[ai][bj][m][n] * rsqrtf(rowss[row] * (1.0f / 1024.0f) + 1e-6f) + bvn;
                        mt[m][0] = bf_lo(cg.x) * xv[0]; mt[m][1] = bf_hi(cg.x) * xv[1]; mt[m][2] = bf_lo(cg.y) * xv[2]; mt[m][3] = bf_hi(cg.y) * xv[3]; }
#pragma unroll
                    for (int j = 0; j < 4; ++j) {
                        float R0, R1, R2, R3, L0, L1, L2, L3;
                        asm("s_nop 1\n\tv_mov_b32_dpp %0, %8 row_ror:1 row_mask:0xf bank_mask:0xf\n\tv_mov_b32_dpp %1, %9 row_ror:1 row_mask:0xf bank_mask:0xf\n\t"
                            "v_mov_b32_dpp %2, %10 row_ror:1 row_mask:0xf bank_mask:0xf\n\tv_mov_b32_dpp %3, %11 row_ror:1 row_mask:0xf bank_mask:0xf\n\t"
                            "v_mov_b32_dpp %4, %8 row_ror:15 row_mask:0xf bank_mask:0xf\n\tv_mov_b32_dpp %5, %9 row_ror:15 row_mask:0xf bank_mask:0xf\n\t"
                            "v_mov_b32_dpp %6, %10 row_ror:15 row_mask:0xf bank_mask:0xf\n\tv_mov_b32_dpp %7, %11 row_ror:15 row_mask:0xf bank_mask:0xf"
                            : "=&v"(R0), "=&v"(R1), "=&v"(R2), "=&v"(R3), "=&v"(L0), "=&v"(L1), "=&v"(L2), "=&v"(L3)
                            : "v"(mt[0][j]), "v"(mt[1][j]), "v"(mt[2][j]), "v"(mt[3][j]));
                        const float Rm[5] = {0.f, R0, R1, R2, R3}, Lm[5] = {L0, L1, L2, L3, 0.f};
#pragma unroll
                        for (int m = 0; m < 4; ++m) { const float pv = fr == 0 ? Rm[m] : Rm[m + 1], nv = fr == 15 ? Lm[m + 1] : Lm[m];
                            mt[m][j] = w0[j] * pv + w1[j] * mt[m][j] + w2[j] * nv; } }
#pragma unroll
                    for (int m = 0; m < 4; ++m) { const int row = r0l + m * 16; const u32x2 bg = *(const u32x2*)(P + (size_t)row * 3072 + c);
                        u32x2 q; q.x = cvt_pk_bf16(bf_lo(bg.x) * mt[m][0], bf_hi(bg.x) * mt[m][1]); q.y = cvt_pk_bf16(bf_lo(bg.y) * mt[m][2], bf_hi(bg.y) * mt[m][3]);
                        *(u32x2*)(V + (size_t)row * 1024 + c) = q; }
                    asm volatile("" ::: "memory");
                }
            }
    }
};
struct EpiRes {
    static constexpr bool PERM = true, AFTER_DRAIN = false;
    const float* xin32; const bf16_t* xinbf; bf16_t* xout; const float* gate; bf16_t* abf; const float* ng; const float* sc; float* rowss;
    __device__ __forceinline__ void operator()(const f32x4 (&acc)[2][2][4][2], const Unit& u, int wr, int wc, int fr, int fq) const {
        const int row0 = u.pm * 256 + wr * 64 + fr, col0 = u.pn * 256 + wc * 32 + 8 * fq, b = u.pm >> 3;
        f32x4 gv[2][2], sv[2][2];
#pragma unroll
        for (int bj = 0; bj < 2; ++bj)
#pragma unroll
            for (int n = 0; n < 2; ++n) { gv[bj][n] = *(const f32x4*)(gate + b * 6144 + col0 + bj * 128 + 4 * n);
                sv[bj][n] = *(const f32x4*)(ng + col0 + bj * 128 + 4 * n) * (*(const f32x4*)(sc + b * 6144 + col0 + bj * 128 + 4 * n) + 1.0f); }
#pragma unroll
        for (int ai = 0; ai < 2; ++ai)
#pragma unroll
            for (int m = 0; m < 4; ++m) { const int row = row0 + ai * 128 + m * 16; const size_t off = (size_t)row * 1024 + col0; float ss = 0.f;
#pragma unroll
                for (int bj = 0; bj < 2; ++bj) { f32x4 x0, x1;
                    if (xin32) { x0 = *(const f32x4*)(xin32 + off + bj * 128); x1 = *(const f32x4*)(xin32 + off + bj * 128 + 4); }
                    else { const u32x4 r = *(const u32x4*)(xinbf + off + bj * 128); x0 = (f32x4){bf_lo(r.x), bf_hi(r.x), bf_lo(r.y), bf_hi(r.y)}; x1 = (f32x4){bf_lo(r.z), bf_hi(r.z), bf_lo(r.w), bf_hi(r.w)}; }
                    const f32x4 xo0 = x0 + gv[bj][0] * acc[ai][bj][m][0], xo1 = x1 + gv[bj][1] * acc[ai][bj][m][1];
                    u32x4 xr; xr.x = cvt_pk_bf16(xo0[0], xo0[1]); xr.y = cvt_pk_bf16(xo0[2], xo0[3]); xr.z = cvt_pk_bf16(xo1[0], xo1[1]); xr.w = cvt_pk_bf16(xo1[2], xo1[3]);
                    *(u32x4*)(xout + off + bj * 128) = xr;
                    ss += xo0[0] * xo0[0] + xo0[1] * xo0[1] + xo0[2] * xo0[2] + xo0[3] * xo0[3] + xo1[0] * xo1[0] + xo1[1] * xo1[1] + xo1[2] * xo1[2] + xo1[3] * xo1[3];
                    const f32x4 a0 = xo0 * sv[bj][0], a1 = xo1 * sv[bj][1];
                    u32x4 w; w.x = cvt_pk_bf16(a0[0], a0[1]); w.y = cvt_pk_bf16(a0[2], a0[3]); w.z = cvt_pk_bf16(a1[0], a1[1]); w.w = cvt_pk_bf16(a1[2], a1[3]); *(u32x4*)(abf + off + bj * 128) = w; }
                ss += __shfl_xor(ss, 16); ss += __shfl_xor(ss, 32); if (fq == 0) atomicAdd(rowss + row, ss);
                asm volatile("" ::: "memory"); }
    }
};

struct EpiResFin {
    static constexpr bool PERM = true, AFTER_DRAIN = true;
    const bf16_t* xinbf; float* out; const float* gate; float* rowss; const float* fin; unsigned* pcnt;
    __device__ __forceinline__ void fused(f32x4 (&acc)[2][2][4][2], const Unit& u, int wr, int wc, int fr, int fq, PG8_LAS unsigned char*, int, int) const {
        const int row0 = u.pm * 256 + wr * 64 + fr, col0 = u.pn * 256 + wc * 32 + 8 * fq, b = u.pm >> 3;
        f32x4 gv[2][2], sv[2][2];
#pragma unroll
        for (int bj = 0; bj < 2; ++bj)
#pragma unroll
            for (int n = 0; n < 2; ++n) { gv[bj][n] = *(const f32x4*)(gate + b * 6144 + col0 + bj * 128 + 4 * n); sv[bj][n] = *(const f32x4*)(fin + col0 + bj * 128 + 4 * n); }
#pragma unroll
        for (int ai = 0; ai < 2; ++ai)
#pragma unroll
            for (int m = 0; m < 4; ++m) { const int row = row0 + ai * 128 + m * 16; const size_t off = (size_t)row * 1024 + col0; float ss = 0.f;
#pragma unroll
                for (int bj = 0; bj < 2; ++bj) { const u32x4 r = *(const u32x4*)(xinbf + off + bj * 128);
                    const f32x4 xo0 = (f32x4){bf_lo(r.x), bf_hi(r.x), bf_lo(r.y), bf_hi(r.y)} + gv[bj][0] * acc[ai][bj][m][0], xo1 = (f32x4){bf_lo(r.z), bf_hi(r.z), bf_lo(r.w), bf_hi(r.w)} + gv[bj][1] * acc[ai][bj][m][1];
                    acc[ai][bj][m][0] = xo0; acc[ai][bj][m][1] = xo1;
                    ss += xo0[0] * xo0[0] + xo0[1] * xo0[1] + xo0[2] * xo0[2] + xo0[3] * xo0[3] + xo1[0] * xo1[0] + xo1[1] * xo1[1] + xo1[2] * xo1[2] + xo1[3] * xo1[3]; }
                ss += __shfl_xor(ss, 16); ss += __shfl_xor(ss, 32); if (fq == 0) atomicAdd(rowss + row, ss);
                asm volatile("" ::: "memory"); }
        asm volatile("s_waitcnt vmcnt(0)" ::: "memory");
        unsigned* cw = pcnt + 64 * u.pm;
        if (fr == 0 && fq == 0) (void)__hip_atomic_fetch_add(cw, 1u, __ATOMIC_RELAXED, __HIP_MEMORY_SCOPE_AGENT);
        { unsigned polls = 0u; while (__hip_atomic_load(cw, __ATOMIC_RELAXED, __HIP_MEMORY_SCOPE_AGENT) < 32u && ++polls < (1u << 18)) __builtin_amdgcn_s_sleep(2); }
#pragma unroll
        for (int ai = 0; ai < 2; ++ai)
#pragma unroll
            for (int m = 0; m < 4; ++m) { const int row = row0 + ai * 128 + m * 16; const size_t off = (size_t)row * 1024 + col0;
                const float rs = rsqrtf(__hip_atomic_load(rowss + row, __ATOMIC_RELAXED, __HIP_MEMORY_SCOPE_AGENT) * (1.0f / 1024.0f) + 1e-6f);
#pragma unroll
                for (int bj = 0; bj < 2; ++bj)
#pragma unroll
                    for (int n = 0; n < 2; ++n) *(f32x4*)(out + off + bj * 128 + 4 * n) = acc[ai][bj][m][n] * rs * sv[bj][n]; }
    }
};

__device__ __forceinline__ void unpack8(const u32x4 v, float (&f)[8]) { f[0] = bf_lo(v.x); f[1] = bf_hi(v.x); f[2] = bf_lo(v.y); f[3] = bf_hi(v.y); f[4] = bf_lo(v.z); f[5] = bf_hi(v.z); f[6] = bf_lo(v.w); f[7] = bf_hi(v.w); }
__device__ __forceinline__ void phase_conv(const Params& p) {
    const int tidx = pg8_tid_fresh();
    const int lane = tidx & 63, wave = tidx >> 6;
    bf16_t* xbc = (bf16_t*)(p.ws + WS_XBC); bf16_t* xbcc = (bf16_t*)(p.ws + WS_XBCC);
    const float* cw = p.in[9]; const float* cb = p.in[10];
    for (int item0 = wave * gridDim.x + blockIdx.x; item0 < 256; item0 += gridDim.x * 8) {
        const int item = item0 + 2048; const int seg = item >> 3, slab = item & 7, ch = slab * 512 + lane * 8;
        const bf16_t* src; bf16_t* dst; bool has_prev = false, has_next = false;
        if (seg < 256) { src = xbc + (size_t)seg * 64 * 4096 + ch; dst = xbc + (size_t)seg * 64 * 4096 + ch; }
        else { const int cs = seg - 256, q = cs & 3; src = xbc + (size_t)(16384 + cs * 64) * 4096 + ch; dst = xbcc + (size_t)cs * 64 * 4096 + ch; has_prev = q > 0; has_next = q < 3; }
        float w0[8], w1[8], w2[8], bb[8];
#pragma unroll
        for (int h = 0; h < 2; ++h) { const f32x4 a = *(const f32x4*)(cw + ch + 4 * h), b = *(const f32x4*)(cw + 4096 + ch + 4 * h), c = *(const f32x4*)(cw + 8192 + ch + 4 * h), d = *(const f32x4*)(cb + ch + 4 * h);
#pragma unroll
            for (int j = 0; j < 4; ++j) { w0[4 * h + j] = a[j]; w1[4 * h + j] = b[j]; w2[4 * h + j] = c[j]; bb[4 * h + j] = d[j]; } }
        u32x4 prev = (u32x4){0u, 0u, 0u, 0u};
        if (has_prev) prev = *(const u32x4*)(src - 4096);
        for (int sb = 0; sb < 4; ++sb) {
            u32x4 r[16];
#pragma unroll
            for (int i = 0; i < 16; ++i) r[i] = *(const u32x4*)(src + (size_t)(sb * 16 + i) * 4096);
            u32x4 nxt = (u32x4){0u, 0u, 0u, 0u};
            if (sb < 3 || has_next) nxt = *(const u32x4*)(src + (size_t)(sb * 16 + 16) * 4096);
            float fp[8], fc[8], fn[8];
            unpack8(prev, fp); unpack8(r[0], fc);
#pragma unroll
            for (int i = 0; i < 16; ++i) {
                unpack8(i < 15 ? r[i < 15 ? i + 1 : 15] : nxt, fn);
                float o[8];
#pragma unroll
                for (int j = 0; j < 8; ++j) { o[j] = silu_f(w0[j] * fp[j] + w1[j] * fc[j] + w2[j] * fn[j] + bb[j]); fp[j] = fc[j]; fc[j] = fn[j]; }
                u32x4 w; w.x = cvt_pk_bf16(o[0], o[1]); w.y = cvt_pk_bf16(o[2], o[3]); w.z = cvt_pk_bf16(o[4], o[5]); w.w = cvt_pk_bf16(o[6], o[7]);
                *(u32x4*)(dst + (size_t)(sb * 16 + i) * 4096) = w;
            }
            prev = r[15];
        }
    }
}

__device__ __forceinline__ bf16x8 ld_frag(ldsp L, int off) { return *(const LASQ bf16x8*)(L + off); }
__device__ __forceinline__ s16x4 tr4(ldsp L, int off) { return __builtin_bit_cast(s16x4, __builtin_amdgcn_ds_read_tr16_b64_v4i16((LASQ v4i16_t*)(L + off))); }
__device__ __forceinline__ bf16x8 tr_frag(ldsp L, int off, int stride) { const s16x4 a = tr4(L, off), b = tr4(L, off + 4 * stride); return (bf16x8){a[0], a[1], a[2], a[3], b[0], b[1], b[2], b[3]}; }
__device__ __forceinline__ unsigned scale2(unsigned u, float s0, float s1) { return cvt_pk_bf16(bf_lo(u) * s0, bf_hi(u) * s1); }
#define LBAR() asm volatile("s_waitcnt lgkmcnt(0)\n\ts_barrier" ::: "memory")
#define MFMA16(a, b, c) __builtin_amdgcn_mfma_f32_16x16x32_bf16((a), (b), (c), 0, 0, 0)

__device__ __forceinline__ void phase_ssd(const Params& p, ldsp L) {
    const int tidx = pg8_tid_fresh();
    constexpr int RS = 272, RSX = 144, CN = 0, BN = 34816, XS = 69632, HB = 88064, CSO = 105472, WO = 105984, TOTO = 106496, CSD = 106512;
    const int tid = tidx, lane = tid & 63, w = __builtin_amdgcn_readfirstlane(tid >> 6), fr = lane & 15, fq = lane >> 4, q4 = fr >> 2, p4 = fr & 3;
    const bf16_t* xbc = (const bf16_t*)(p.ws + WS_XBC); const bf16_t* xbcc = (const bf16_t*)(p.ws + WS_XBCC);
    const float* dtb = (const float*)(p.ws + WS_DT); bf16_t* yb = (bf16_t*)(p.ws + WS_R);
    LASQ float* csf = (LASQ float*)(L + CSO); LASQ float* wf = (LASQ float*)(L + WO); LASQ float* totf = (LASQ float*)(L + TOTO); LASQ float* csd = (LASQ float*)(L + CSD);
    const int pw = w & 3, nb0 = (w >> 2) * 4;
    const int tb = w < 4 ? w : 11 - w;
    const int trow = 16 * tb + fr;
    const int xrow0 = tid >> 3, xpc = tid & 7, brow0 = tid >> 4, bpc = tid & 15;
    for (int it = blockIdx.x; it < 256; it += gridDim.x) {
        const int xcd = it & 7, slot = it >> 3, pgi = xcd * 8 + (slot >> 2), r = slot & 3, b = pgi >> 3, g = pgi & 7, head = g * 4 + r;
        const float Dh = p.in[13][head];
        f32x4 hacc[4];
        u32x4 px[2], pb[4], pc[4]; float pa0 = 0.f, pa1 = 0.f;
        const unsigned vX0 = (unsigned)(xrow0 * 4096 + head * 64 + xpc * 8), vB0 = (unsigned)(brow0 * 4096 + 2048 + g * 128 + bpc * 8), vD0 = (unsigned)(lane * 64);
        const unsigned vY = (unsigned)(trow * 2048 + head * 64 + 8 * fq);
#define SSD_PREFETCH(sidx_) do { const int dir_ = (sidx_) >= 18 ? 1 : 0, step_ = (sidx_) - 18 * dir_; const bool isctx_ = step_ < 2; \
            const int c_ = isctx_ ? (dir_ ? 1 - step_ : step_) : (dir_ ? 17 - step_ : step_ - 2); \
            const bf16_t* src_ = isctx_ ? xbc + (size_t)(16384 + b * 256 + c_ * 128) * 4096 : xbc + (size_t)(b * 2048 + c_ * 128) * 4096; \
            const int grow_ = isctx_ ? 16384 + b * 256 + c_ * 128 : b * 2048 + c_ * 128; \
            const float* dtp_ = dtb + (size_t)grow_ * 64 + dir_ * 32 + head; \
            _Pragma("unroll") for (int i = 0; i < 2; ++i) px[i] = *(const u32x4*)(src_ + (vX0 + (unsigned)(i * 64 * 4096))); \
            _Pragma("unroll") for (int i = 0; i < 4; ++i) { pb[i] = *(const u32x4*)(src_ + (vB0 + (unsigned)(i * 32 * 4096))); pc[i] = *(const u32x4*)(src_ + (vB0 + (unsigned)(i * 32 * 4096 + 1024))); } \
            if (w == 0) { pa0 = dtp_[vD0]; pa1 = dtp_[vD0 + 4096u]; } } while (0)
        SSD_PREFETCH(0);
        float A = 0.f;
#pragma unroll 1
        for (int sidx = 0; sidx < 36; ++sidx) {
            const int dir = sidx >= 18 ? 1 : 0, step = sidx - 18 * dir;
            if (step == 0) { A = -__expf(p.in[12][dir * 32 + head]);
#pragma unroll
                for (int i = 0; i < 4; ++i) hacc[i] = (f32x4){0.f, 0.f, 0.f, 0.f}; }
            const bool isctx = step < 2;
            const int c = isctx ? (dir ? 1 - step : step) : (dir ? 17 - step : step - 2);
            const int grow0 = isctx ? 16384 + b * 256 + c * 128 : b * 2048 + c * 128;
#pragma unroll
            for (int i = 0; i < 2; ++i) { const int row = xrow0 + 64 * i; u32x2 lo, hi; lo.x = px[i].x; lo.y = px[i].y; hi.x = px[i].z; hi.y = px[i].w;
                *(LASQ u32x2*)(L + XS + row * RSX + (32 * (xpc >> 2) + 4 * (xpc & 3)) * 2) = lo; *(LASQ u32x2*)(L + XS + row * RSX + (32 * (xpc >> 2) + 16 + 4 * (xpc & 3)) * 2) = hi; }
#pragma unroll
            for (int i = 0; i < 4; ++i) { const int row = brow0 + 32 * i; *(LASQ u32x4*)(L + BN + row * RS + bpc * 16) = pb[i]; *(LASQ u32x4*)(L + CN + row * RS + bpc * 16) = pc[i]; }
            if (!isctx) {
#pragma unroll
                for (int i = 0; i < 4; ++i) { u32x2 hw; hw.x = cvt_pk_bf16(hacc[i][0], hacc[i][1]); hw.y = cvt_pk_bf16(hacc[i][2], hacc[i][3]);
                    *(LASQ u32x2*)(L + HB + (16 * pw + fr) * RS + (16 * (nb0 + i) + 4 * fq) * 2) = hw; }
            }
            if (w == 0) {
                const float a0 = pa0 * A * 1.44269504089f, a1 = pa1 * A * 1.44269504089f;
                float p0 = a0, p1 = a1;
#pragma unroll
                for (int o = 1; o < 64; o <<= 1) { const float t0 = __shfl_up(p0, o), t1 = __shfl_up(p1, o); if (lane >= o) { p0 += t0; p1 += t1; } }
                p1 += __shfl(p0, 63);
                const float total = __shfl(p1, 63);
                if (dir) { p0 = total - p0 + a0; p1 = total - p1 + a1; }
                csf[lane] = p0; csf[64 + lane] = p1; csd[lane] = p0 - __builtin_amdgcn_logf(pa0); csd[64 + lane] = p1 - __builtin_amdgcn_logf(pa1);
                wf[lane] = __builtin_amdgcn_exp2f(total - p0) * pa0; wf[64 + lane] = __builtin_amdgcn_exp2f(total - p1) * pa1;
                if (lane == 0) totf[0] = total;
            }
            if (sidx + 1 < 36) SSD_PREFETCH(sidx + 1);
            bf16_t* ybase = yb + (size_t)grow0 * 2048;
            u32x4 pv[2];
            if (!isctx && dir == 1) {
#pragma unroll
                for (int q = 0; q < 2; ++q) pv[q] = *(const u32x4*)(ybase + (vY + 32u * q));
            }
            LBAR0();
            const float total = totf[0];
            if (!isctx) {
                const float cst = csf[trow];
                bf16x8 cf[4];
#pragma unroll
                for (int ks = 0; ks < 4; ++ks) cf[ks] = ld_frag(L, CN + trow * RS + ks * 64 + fq * 16);
                f32x4 yacc[4];
#pragma unroll
                for (int pt = 0; pt < 4; ++pt) { yacc[pt] = (f32x4){0.f, 0.f, 0.f, 0.f};
#pragma unroll
                    for (int ks = 0; ks < 4; ++ks) { const bf16x8 hf = ld_frag(L, HB + (16 * pt + fr) * RS + ks * 64 + fq * 16); yacc[pt] = MFMA16(hf, cf[ks], yacc[pt]); } }
                const float ect = __builtin_amdgcn_exp2f(cst);
#pragma unroll
                for (int pt = 0; pt < 4; ++pt) yacc[pt] *= ect;
                const int ks_lo = dir ? (tb >> 1) : 0, ks_hi = dir ? 3 : (tb >> 1);
#pragma unroll 1
                for (int kp = ks_lo; kp <= ks_hi; ++kp) {
                    f32x4 s0 = (f32x4){0.f, 0.f, 0.f, 0.f}, s1 = (f32x4){0.f, 0.f, 0.f, 0.f};
#pragma unroll
                    for (int ks = 0; ks < 4; ++ks) { const bf16x8 b0 = ld_frag(L, BN + (32 * kp + fr) * RS + ks * 64 + fq * 16), b1 = ld_frag(L, BN + (32 * kp + 16 + fr) * RS + ks * 64 + fq * 16);
                        s0 = MFMA16(b0, cf[ks], s0); s1 = MFMA16(b1, cf[ks], s1); }
                    s16x4 xa[4], xb[4];
#pragma unroll
                    for (int pt = 0; pt < 4; ++pt) { xa[pt] = tr4(L, XS + (32 * kp + 4 * fq + q4) * RSX + 32 * pt + 8 * p4); xb[pt] = tr4(L, XS + (32 * kp + 16 + 4 * fq + q4) * RSX + 32 * pt + 8 * p4); }
                    const f32x4 c0 = *(const LASQ f32x4*)(L + CSD + (32 * kp + 4 * fq) * 4), c1 = *(const LASQ f32x4*)(L + CSD + (32 * kp + 16 + 4 * fq) * 4);
                    float l0[4], l1[4];
#pragma unroll
                    for (int j = 0; j < 4; ++j) { const int si = 32 * kp + 4 * fq + j; const bool ok0 = dir ? (si >= trow) : (si <= trow), ok1 = dir ? (si + 16 >= trow) : (si + 16 <= trow);
                        l0[j] = ok0 ? s0[j] * __builtin_amdgcn_exp2f(cst - c0[j]) : 0.f; l1[j] = ok1 ? s1[j] * __builtin_amdgcn_exp2f(cst - c1[j]) : 0.f; }
                    u32x4 lu; lu.x = cvt_pk_bf16(l0[0], l0[1]); lu.y = cvt_pk_bf16(l0[2], l0[3]); lu.z = cvt_pk_bf16(l1[0], l1[1]); lu.w = cvt_pk_bf16(l1[2], l1[3]);
                    const bf16x8 lf = __builtin_bit_cast(bf16x8, lu);
#pragma unroll
                    for (int pt = 0; pt < 4; ++pt) { const bf16x8 xf = (bf16x8){xa[pt][0], xa[pt][1], xa[pt][2], xa[pt][3], xb[pt][0], xb[pt][1], xb[pt][2], xb[pt][3]}; yacc[pt] = MFMA16(xf, lf, yacc[pt]); }
                }
                if (dir == 0) {
#pragma unroll
                    for (int q = 0; q < 2; ++q) { u32x4 o; o.x = cvt_pk_bf16(yacc[2 * q][0], yacc[2 * q][1]); o.y = cvt_pk_bf16(yacc[2 * q][2], yacc[2 * q][3]);
                        o.z = cvt_pk_bf16(yacc[2 * q + 1][0], yacc[2 * q + 1][1]); o.w = cvt_pk_bf16(yacc[2 * q + 1][2], yacc[2 * q + 1][3]);
                        *(u32x4*)(ybase + (vY + 32u * q)) = o; }
                } else {
#pragma unroll
                    for (int q = 0; q < 2; ++q) {
                        const u32x2 xa = *(const LASQ u32x2*)(L + XS + trow * RSX + (32 * q + 4 * fq) * 2), xb = *(const LASQ u32x2*)(L + XS + trow * RSX + (32 * q + 16 + 4 * fq) * 2);
                        u32x4 o;
                        o.x = cvt_pk_bf16(yacc[2 * q][0] + bf_lo(pv[q].x) + Dh * bf_lo(xa.x), yacc[2 * q][1] + bf_hi(pv[q].x) + Dh * bf_hi(xa.x));
                        o.y = cvt_pk_bf16(yacc[2 * q][2] + bf_lo(pv[q].y) + Dh * bf_lo(xa.y), yacc[2 * q][3] + bf_hi(pv[q].y) + Dh * bf_hi(xa.y));
                        o.z = cvt_pk_bf16(yacc[2 * q + 1][0] + bf_lo(pv[q].z) + Dh * bf_lo(xb.x), yacc[2 * q + 1][1] + bf_hi(pv[q].z) + Dh * bf_hi(xb.x));
                        o.w = cvt_pk_bf16(yacc[2 * q + 1][2] + bf_lo(pv[q].w) + Dh * bf_lo(xb.y), yacc[2 * q + 1][3] + bf_hi(pv[q].w) + Dh * bf_hi(xb.y));
                        *(u32x4*)(ybase + (vY + 32u * q)) = o; }
                }
            }
            { const float et = __builtin_amdgcn_exp2f(total);
#pragma unroll
              for (int i = 0; i < 4; ++i) hacc[i] *= et;
#pragma unroll
              for (int ks = 0; ks < 4; ++ks) {
                  const bf16x8 xr = tr_frag(L, XS + (32 * ks + 8 * fq + q4) * RSX + 32 * pw + 8 * p4, RSX);
                  const f32x4 wa = *(const LASQ f32x4*)(L + WO + (32 * ks + 8 * fq) * 4), wb = *(const LASQ f32x4*)(L + WO + (32 * ks + 8 * fq + 4) * 4);
                  const u32x4 xu = __builtin_bit_cast(u32x4, xr); u32x4 xs;
                  xs.x = scale2(xu.x, wa[0], wa[1]); xs.y = scale2(xu.y, wa[2], wa[3]); xs.z = scale2(xu.z, wb[0], wb[1]); xs.w = scale2(xu.w, wb[2], wb[3]);
                  const bf16x8 xsf = __builtin_bit_cast(bf16x8, xs);
#pragma unroll
                  for (int i = 0; i < 4; ++i) { const bf16x8 bfr = tr_frag(L, BN + (32 * ks + 8 * fq + q4) * RS + 32 * (nb0 + i) + 8 * p4, RS); hacc[i] = MFMA16(bfr, xsf, hacc[i]); } } }
            LBAR0();
        }
#undef SSD_PREFETCH
    }
}

__device__ __forceinline__ void phase_gnorm(const Params& p) {
    const int tidx = pg8_tid_fresh();
    const int lane = tidx & 63, wave = tidx >> 6, stride = gridDim.x * 8;
    bf16_t* yb = (bf16_t*)(p.ws + WS_R); const bf16_t* zb = (const bf16_t*)p.out; const float* ng = p.in[14];
    for (int r0 = blockIdx.x * 8 + wave; r0 < 16384; r0 += 2 * stride) {
        u32x4 v[2][4], zz[2][4];
#pragma unroll
        for (int u = 0; u < 2; ++u) { const int r = r0 + u * stride < 16384 ? r0 + u * stride : r0;
#pragma unroll
            for (int i = 0; i < 4; ++i) { const int col = i * 512 + lane * 8; v[u][i] = *(const u32x4*)(yb + (size_t)r * 2048 + col); zz[u][i] = *(const u32x4*)(zb + (size_t)r * 2048 + col); } }
#pragma unroll
        for (int u = 0; u < 2; ++u) { const int r = r0 + u * stride;
#pragma unroll
            for (int i = 0; i < 4; ++i) { const int col = i * 512 + lane * 8; float y[8], z[8]; unpack8(v[u][i], y); unpack8(zz[u][i], z); float sq = 0.f;
#pragma unroll
                for (int j = 0; j < 8; ++j) { y[j] *= silu_f(z[j]); sq += y[j] * y[j]; }
                sq += __shfl_xor(sq, 16); sq += __shfl_xor(sq, 8); sq += __shfl_xor(sq, 4); sq += __shfl_xor(sq, 2); sq += __shfl_xor(sq, 1);
                const float s = rsqrtf(sq * (1.0f / 256.0f) + 1e-6f);
                const f32x4 g0 = *(const f32x4*)(ng + col), g1 = *(const f32x4*)(ng + col + 4); u32x4 o;
                o.x = cvt_pk_bf16((y[0] * s) * g0[0], (y[1] * s) * g0[1]); o.y = cvt_pk_bf16((y[2] * s) * g0[2], (y[3] * s) * g0[3]);
                o.z = cvt_pk_bf16((y[4] * s) * g1[0], (y[5] * s) * g1[1]); o.w = cvt_pk_bf16((y[6] * s) * g1[2], (y[7] * s) * g1[3]);
                if (r < 16384) *(u32x4*)(yb + (size_t)r * 2048 + col) = o; } }
    }
}

__device__ __forceinline__ void phase_scconv(const Params& p) {
    const int tidx = pg8_tid_fresh();
    const int lane = tidx & 63, wave = tidx >> 6;
    const bf16_t* P = (const bf16_t*)(p.ws + WS_SCP); bf16_t* V = (bf16_t*)(p.ws + WS_SCV); const float* cw = p.in[17];
    for (int item = blockIdx.x * 8 + wave; item < 8192; item += gridDim.x * 8) {
        const int rb = item >> 1, half = item & 1, ch = half * 512 + lane * 8, t0 = rb * 4, tin = t0 & 63;
        float w0[8], w1[8], w2[8];
#pragma unroll
        for (int h = 0; h < 2; ++h) { const f32x4 a = *(const f32x4*)(cw + ch + 4 * h), b = *(const f32x4*)(cw + 1024 + ch + 4 * h), c = *(const f32x4*)(cw + 2048 + ch + 4 * h);
#pragma unroll
            for (int j = 0; j < 4; ++j) { w0[4 * h + j] = a[j]; w1[4 * h + j] = b[j]; w2[4 * h + j] = c[j]; } }
        float m[6][8];
#pragma unroll
        for (int i = 0; i < 6; ++i) { const int t = t0 - 1 + i; const bool ok = !((i == 0 && tin == 0) || (i == 5 && tin == 60));
            if (ok) { const u32x4 cg = *(const u32x4*)(P + (size_t)t * 3072 + 1024 + ch), xv = *(const u32x4*)(P + (size_t)t * 3072 + 2048 + ch); float a[8], b[8]; unpack8(cg, a); unpack8(xv, b);
#pragma unroll
                for (int j = 0; j < 8; ++j) m[i][j] = a[j] * b[j]; }
            else {
#pragma unroll
                for (int j = 0; j < 8; ++j) m[i][j] = 0.f; } }
#pragma unroll
        for (int i = 0; i < 4; ++i) { const u32x4 bg = *(const u32x4*)(P + (size_t)(t0 + i) * 3072 + ch); float bgf[8], o[8]; unpack8(bg, bgf);
#pragma unroll
            for (int j = 0; j < 8; ++j) o[j] = bgf[j] * (w0[j] * m[i][j] + w1[j] * m[i + 1][j] + w2[j] * m[i + 2][j]);
            u32x4 w; w.x = cvt_pk_bf16(o[0], o[1]); w.y = cvt_pk_bf16(o[2], o[3]); w.z = cvt_pk_bf16(o[4], o[5]); w.w = cvt_pk_bf16(o[6], o[7]);
            *(u32x4*)(V + (size_t)(t0 + i) * 1024 + ch) = w; }
    }
}


#define XB_TMO      128
#define XB_XCNT(j)  (256  + 64 * (j))
#define XB_XSUB(j)  (1280 + 64 * (j))
#define XB_XGEN(j)  (2304 + 64 * (j))
#define XB_TOP      3328
#define XB_TOPGEN   3392
#define XCD_BAR_WORDS 3456
#define XB_SPIN_CAP (1u << 18)
__device__ __forceinline__ unsigned xb_ld(unsigned* p)              { return __hip_atomic_load(p, __ATOMIC_RELAXED, __HIP_MEMORY_SCOPE_AGENT); }
__device__ __forceinline__ unsigned xb_add(unsigned* p, unsigned v) { return __hip_atomic_fetch_add(p, v, __ATOMIC_RELAXED, __HIP_MEMORY_SCOPE_AGENT); }
__device__ __forceinline__ unsigned xb_xcc_id() { return (unsigned)__builtin_amdgcn_s_getreg((3 << 11) | 20) & 0xFu; }
#define XB_SPIN(cond, bar) do { unsigned _sp = 0; while (cond) { __builtin_amdgcn_s_sleep(1); \
    if ((++_sp & 255u) == 0u) { if (xb_ld(&(bar)[XB_TMO])) break; if (_sp > XB_SPIN_CAP) { atomicAdd(&(bar)[XB_TMO], 1u); break; } } } } while (0)
struct XcdBarrier { unsigned* bar; unsigned x; volatile LASQ unsigned* st; };
__device__ __forceinline__ XcdBarrier xcd_barrier_post(unsigned* bar, volatile LASQ unsigned* st) {
    XcdBarrier b; b.bar = bar; b.x = xb_xcc_id(); b.st = st;
    if (threadIdx.x == 0) (void)xb_add(&bar[XB_XCNT(b.x)], 1u);
    return b;
}
__device__ __forceinline__ void xcd_barrier_complete(unsigned* bar, unsigned x, unsigned& nloc, unsigned& nx) {
    const unsigned G = gridDim.x * gridDim.y * gridDim.z;
    unsigned sum, cnt, mine, sp = 0u;
    for (;;) {
        sum = 0u; cnt = 0u; mine = 0u;
#pragma unroll
        for (unsigned j = 0; j < 16; ++j) { const unsigned c = xb_ld(&bar[XB_XCNT(j)]); sum += c; cnt += (c > 0u) ? 1u : 0u; mine = (j == x) ? c : mine; }
        if (sum == G) break;
        __builtin_amdgcn_s_sleep(1);
        if ((++sp & 255u) == 0u) { if (xb_ld(&bar[XB_TMO])) break; if (sp > XB_SPIN_CAP) { atomicAdd(&bar[XB_TMO], 1u); break; } }
    }
    nloc = mine > 0u ? mine : 1u; nx = cnt > 0u ? cnt : 1u;
}
__device__ __forceinline__ void xcd_barrier(const XcdBarrier& b) {
    asm volatile("s_waitcnt vmcnt(0)" ::: "memory");
    __syncthreads();
    if (threadIdx.x == 0) {
        unsigned* bar = b.bar;
        __builtin_amdgcn_s_waitcnt(0);
        unsigned nloc = b.st[0], nx = b.st[1];
        if (nloc == 0u) { xcd_barrier_complete(bar, b.x, nloc, nx); b.st[0] = nloc; b.st[1] = nx; }
        const unsigned old = xb_add(&bar[XB_XSUB(b.x)], 1u);
        const unsigned gen = old / nloc;
        if (old + 1u == (gen + 1u) * nloc) {
            __builtin_amdgcn_fence(__ATOMIC_RELEASE, "agent");
            asm volatile("s_waitcnt vmcnt(0)" ::: "memory");
            const unsigned og = xb_add(&bar[XB_TOP], 1u);
            const unsigned tg = og / nx;
            if (og + 1u == (tg + 1u) * nx) xb_add(&bar[XB_TOPGEN], 1u);
            else XB_SPIN(xb_ld(&bar[XB_TOPGEN]) == tg, bar);
            __builtin_amdgcn_fence(__ATOMIC_ACQUIRE, "agent");
            xb_add(&bar[XB_XGEN(b.x)], 1u);
            asm volatile("s_waitcnt vmcnt(0)" ::: "memory");
        } else {
            XB_SPIN(xb_ld(&bar[XB_XGEN(b.x)]) == gen, bar);
            __builtin_amdgcn_fence(__ATOMIC_ACQUIRE, "agent");
            asm volatile("s_waitcnt vmcnt(0)" ::: "memory");
        }
    }
    __syncthreads();
}
constexpr int PROBE_ID = 0, PROBE_MULT = 4;
#define PB(id) do { if (PROBE_ID == (id) && blockIdx.x == 0) { tp0 = __builtin_amdgcn_s_memrealtime(); } } while (0)
#define PE(id) do { if (PROBE_ID == (id) && blockIdx.x == 0) { tacc += __builtin_amdgcn_s_memrealtime() - tp0; } } while (0)
#define GSYNC() do { PB(13); xcd_barrier(xbar); PE(13); } while (0)
__global__ void __launch_bounds__(512, 2) mega(Params p) {
    unsigned long long tp0 = 0, tacc = 0;
    extern __shared__ __attribute__((aligned(16))) unsigned char lds[];
    cg::grid_group grid = cg::this_grid();
    PG8_LAS unsigned char* L = (PG8_LAS unsigned char*)lds;
    const int G = gridDim.x, bx = blockIdx.x; const int tidx = pg8_tid_fresh();
    float* mod = (float*)(p.ws + WS_MOD);
    bf16_t* hA = (bf16_t*)(p.ws + WS_R);
    if (threadIdx.x < 4) ((volatile LASQ unsigned*)(L + 131072))[threadIdx.x] = 0u;
    __syncthreads();
    XcdBarrier xbar = xcd_barrier_post((unsigned*)(p.ws + WS_BAR), (volatile LASQ unsigned*)(L + 131072));
    if (p.ws == nullptr) grid.sync();
    PB(1);
    { float* ssq = (float*)(p.ws + WS_SSQ); for (int i = bx * NT + tidx; i < 131072; i += G * NT) ssq[i] = 0.f;
      { float* z2 = (float*)(p.ws + WS_SMALL2); for (int i = bx * NT + tidx; i < (int)((WS_SMALL2_END - WS_SMALL2) / 4); i += G * NT) z2[i] = 0.f; }
      phase_ada(p, lds);
      int g = bx, base = 0; TrJob j0{p.in[8], (bf16_t*)(p.ws + WS_WIN), 1024, 6208}, j1{p.in[15], (bf16_t*)(p.ws + WS_WOUT), 2048, 1024};
      tr_job(j0, g, base, (float*)lds); tr_job(j1, g, base, (float*)lds); }
    GSYNC();
    norm_rows(p.in[0], 16384, -1, p.in[6], mod, 0, 1024, hA);
    norm_rows(p.in[2], 2048, 8, p.in[6], mod, 0, 1024, hA + (size_t)16384 * 1024);
    GSYNC();
    PE(1); PB(2);
    { pg8::Gemm g{hA, (const bf16_t*)(p.ws + WS_WIN), 18432, 6400, 1024}; InProjOrder S; S.init(G, bx);
      EpiInProj E{(bf16_t*)p.out, (bf16_t*)(p.ws + WS_XBC), (float*)(p.ws + WS_DT), p.in[11], p.in[9], p.in[10], L + 131088};
      pg8::gemm_phase<EpiInProj, InProjOrder, true, true>(L, g, S, E); }
    GSYNC();
    PE(2); PB(4);
    phase_ssd(p, L);
    GSYNC();
    PE(4); PB(5);
    phase_gnorm(p);
    { int g = bx, base = 0; const float* mod1 = mod + 9 * 6144;
      TrJob j0{p.in[19], (bf16_t*)(p.ws + WS_W1T0), 1024, 4096}, j1{p.in[20], (bf16_t*)(p.ws + WS_W2T0), 4096, 1024},
            j2{p.in[16], (bf16_t*)(p.ws + WS_SCIN2), 1024, 3072}, j3{p.in[18], (bf16_t*)(p.ws + WS_SCOUT2), 1024, 1024};
      tr_job(j0, g, base, (float*)lds, mod + 3072, (float*)(p.ws + WS_BW1)); tr_job(j1, g, base, (float*)lds);
      tr_job(j2, g, base, (float*)lds, mod1, (float*)(p.ws + WS_BSC)); tr_job(j3, g, base, (float*)lds); }
    GSYNC();
    PE(5);
#pragma unroll 1
    for (int l = 0; l < 2; ++l) {
        int bxi = bx; asm volatile("" : "+s"(bxi));
        const float* modl = mod + l * 9 * 6144;
        float* rowss = (float*)(p.ws + WS_ROWSS);
        bf16_t* const res0 = (bf16_t*)p.out; bf16_t* const a2buf = (bf16_t*)p.out + (size_t)16384 * 1024; bf16_t* const res1 = (bf16_t*)(p.ws + WS_A2);
        bf16_t* Amlp = l == 0 ? (bf16_t*)(p.ws + WS_A1) : a2buf;
        if (l == 0) PB(6);
        { pg8::Gemm g{l == 0 ? (const bf16_t*)(p.ws + WS_R) : (const bf16_t*)(p.ws + WS_SCV), l == 0 ? (const bf16_t*)(p.ws + WS_WOUT) : (const bf16_t*)(p.ws + WS_SCOUT2), 16384, 1024, l == 0 ? 2048 : 1024};
          pg8::StaticOrder S; S.init(16384, 1024, G, bxi);
          EpiRes E{l == 0 ? p.in[0] : (const float*)nullptr, res1, l == 0 ? res0 : res1, modl + 2048, Amlp, p.in[7] + l * 1024, modl + 4096, rowss + (l == 0 ? 0 : 2 * 16384)};
          pg8::gemm_phase<EpiRes, pg8::StaticOrder, true, true>(L, g, S, E); }
        GSYNC();
        if (l == 0) { PE(6); }
        PB(8);
        { pg8::Gemm g{Amlp, l == 0 ? (const bf16_t*)(p.ws + WS_W1T0) : (const bf16_t*)(p.ws + WS_W1T1), 16384, 4096, 1024}; pg8::StaticOrder S; S.init(16384, 4096, G, bxi);
          EpiAct E{(bf16_t*)(p.ws + WS_U2), 4096, 1, rowss + (l == 0 ? 0 : 2 * 16384), (const float*)(p.ws + WS_BW1) + (size_t)l * 8 * 4096};
          pg8::gemm_phase<EpiAct, pg8::StaticOrder, true, true>(L, g, S, E); }
        GSYNC();
        PE(8); PB(9);
        if (l == 0) {
            pg8::Gemm g{(const bf16_t*)(p.ws + WS_U2), (const bf16_t*)(p.ws + WS_W2T0), 16384, 1024, 4096}; pg8::StaticOrder S; S.init(16384, 1024, G, bxi);
            EpiRes E{(const float*)nullptr, res0, res1, modl + 5120, a2buf, p.in[6] + 1024, mod + 9 * 6144 + 1024, rowss + 16384};
            pg8::gemm_phase<EpiRes, pg8::StaticOrder, true, true>(L, g, S, E);
        } else {
            pg8::Gemm g{(const bf16_t*)(p.ws + WS_U2), (const bf16_t*)(p.ws + WS_W2T1), 16384, 1024, 4096}; pg8::StaticOrder S; S.init(16384, 1024, G, bxi);
            EpiResFin E{res1, p.out, modl + 5120, rowss + 3 * 16384, p.in[21], (unsigned*)(p.ws + WS_PCNT)};
            pg8::gemm_phase<EpiResFin, pg8::StaticOrder, false, true>(L, g, S, E);
        }
        if (l == 0) GSYNC();
        PE(9);
        if (l == 0) {
            PB(11);
            { pg8::Gemm g{a2buf, (const bf16_t*)(p.ws + WS_SCIN2), 16384, 3072, 1024}; int bxl = bxi; asm volatile("" : "+s"(bxl));
              ScInOrder S; S.init(G, bxl);
              EpiScIn E{(bf16_t*)(p.ws + WS_SCP), (bf16_t*)(p.ws + WS_SCV), rowss + 16384, (const float*)(p.ws + WS_BSC), p.in[17]};
              pg8::gemm_phase<EpiScIn, ScInOrder, true, true>(L, g, S, E); }
            PE(11); PB(12);
            { int g = bx, base = 0; const float* mod1 = mod + 9 * 6144;
              TrJob j0{p.in[19] + (size_t)1024 * 4096, (bf16_t*)(p.ws + WS_W1T1), 1024, 4096}, j1{p.in[20] + (size_t)4096 * 1024, (bf16_t*)(p.ws + WS_W2T1), 4096, 1024};
              tr_job(j0, g, base, (float*)lds, mod1 + 3072, (float*)(p.ws + WS_BW1) + (size_t)8 * 4096); tr_job(j1, g, base, (float*)lds); }
            GSYNC();
            PE(12);
        }
    }
    if (PROBE_ID != 0 && blockIdx.x == 0) { const unsigned long long ts = __builtin_amdgcn_s_memrealtime(); while (__builtin_amdgcn_s_memrealtime() - ts < (unsigned long long)PROBE_MULT * tacc) __builtin_amdgcn_s_sleep(20); }
}

extern "C" void kernel_launch(void* const* d_in, const int* in_sizes, int n_in, void* d_out, int out_size, void* d_ws, size_t ws_size, hipStream_t stream) {
    static int grid_blocks = 0;
    if (!grid_blocks) {
        int dev = 0, cus = 0, per_cu = 0;
        hipGetDevice(&dev);
        hipDeviceGetAttribute(&cus, hipDeviceAttributeMultiprocessorCount, dev);
        if (hipFuncSetAttribute((const void*)mega, hipFuncAttributeMaxDynamicSharedMemorySize, LDS_BYTES) != hipSuccess) fprintf(stderr, "kernel_launch: hipFuncSetAttribute failed\n");
        hipOccupancyMaxActiveBlocksPerMultiprocessor(&per_cu, (const void*)mega, NT, LDS_BYTES);
        if (per_cu < 1) { fprintf(stderr, "kernel_launch: occupancy query says %d blocks per CU\n", per_cu); per_cu = 1; }
        grid_blocks = cus;
        if (n_in != 22 || ws_size < WS_END_A) fprintf(stderr, "kernel_launch: unexpected n_in %d / ws_size %zu\n", n_in, ws_size);
    }
    Params p{};
    for (int i = 0; i < 22; ++i) p.in[i] = (const float*)d_in[i];
    p.out = (float*)d_out; p.ws = (unsigned char*)d_ws;
    (void)hipMemsetAsync((unsigned char*)d_ws + WS_BAR, 0, XCD_BAR_WORDS * 4, stream);
    void* args[] = {&p};
    hipError_t e = hipLaunchCooperativeKernel((const void*)mega, dim3(grid_blocks), dim3(NT), args, LDS_BYTES, stream);
    if (e != hipSuccess) fprintf(stderr, "cooperative launch failed: %s (grid %d)\n", hipGetErrorString(e), grid_blocks);
}
```
